# Optimizing an MI355X kernel written in HIP

```python
import jax, jax.numpy as jnp
from jax import lax
import numpy as np

D_MODEL = 2048
BATCH = 4
SEQ = 2048
DEPTH = 4

CHUNK = 64
D_MIX = D_MODEL
D_GLA = D_MIX // 2
D_ATT = D_MIX - D_GLA
GLA_HEADS = 4
GLA_DK = D_GLA // 2 // GLA_HEADS
GLA_DV = D_GLA // GLA_HEADS
GLA_KW = GLA_HEADS * GLA_DK
GLA_GATE_RANK = 16
GLA_TAU = 16.0
ATT_HEADS = 8
ATT_HD = D_ATT // ATT_HEADS
LEFT_CHUNKS = 8
BAND = (LEFT_CHUNKS + 1) * CHUNK
REL_CLIP = 128
N_REL = 2 * REL_CLIP + 1
EPS = 1e-6

SPLIT_SIZES = (GLA_KW, GLA_KW, D_GLA, D_GLA, GLA_GATE_RANK, D_ATT, D_ATT, D_ATT, D_ATT)
D_IN = GLA_KW * 2 + D_GLA * 2 + GLA_GATE_RANK + D_ATT * 4

kernel_name = "hymba_gla_chunkattn_sandwich"


def rmsnorm(x, g):
    xf = x.astype(jnp.float32)
    y = xf * lax.rsqrt(jnp.mean(xf * xf, axis=-1, keepdims=True) + EPS) * g.astype(jnp.float32)
    return y.astype(x.dtype)


def split_columns(z):
    points = []
    acc = 0
    for s in SPLIT_SIZES[:-1]:
        acc += s
        points.append(acc)
    return jnp.split(z, points, axis=-1)


def gla_chunk_causal(q, k, v, log_a):
    out_dtype = v.dtype
    B, S, H, DK = q.shape
    DV = v.shape[-1]
    nc = S // CHUNK
    qf = q.astype(jnp.float32).reshape(B, nc, CHUNK, H, DK) * (DK ** -0.5)
    kf = k.astype(jnp.float32).reshape(B, nc, CHUNK, H, DK)
    vf = v.astype(jnp.float32).reshape(B, nc, CHUNK, H, DV)
    L = jnp.cumsum(log_a.astype(jnp.float32).reshape(B, nc, CHUNK, H, DK), axis=2)
    L_end = L[:, :, -1]
    k_dec = kf * jnp.exp(L_end[:, :, None] - L)
    U = jnp.einsum('bnchk,bnchv->bnhkv', k_dec, vf)
    A = jnp.exp(L_end)

    def step(state, inp):
        a, u = inp
        new = a[..., None] * state + u
        return new, new

    init = jnp.zeros((B, H, DK, DV), jnp.float32)
    _, states = lax.scan(step, init, (jnp.swapaxes(A, 0, 1), jnp.swapaxes(U, 0, 1)))
    states = jnp.swapaxes(states, 0, 1)
    o = jnp.einsum('bnchk,bnhkv->bnchv', qf, states)
    return o.reshape(B, S, H, DV).astype(out_dtype)


def chunk_band_attention(q, k, v, rel_bias):
    B, S, H, D = q.shape
    nc = S // CHUNK
    qc = q.reshape(B, nc, CHUNK, H, D)
    pad = ((0, 0), (LEFT_CHUNKS * CHUNK, 0), (0, 0), (0, 0))
    kp = jnp.pad(k, pad).reshape(B, nc + LEFT_CHUNKS, CHUNK, H, D)
    vp = jnp.pad(v, pad).reshape(B, nc + LEFT_CHUNKS, CHUNK, H, D)
    band_idx = jnp.arange(nc)[:, None] + jnp.arange(LEFT_CHUNKS + 1)[None, :]
    kb = kp[:, band_idx].reshape(B, nc, BAND, H, D)
    vb = vp[:, band_idx].reshape(B, nc, BAND, H, D)
    scores = jnp.einsum('bnqhd,bnkhd->bnhqk', qc, kb,
                        preferred_element_type=jnp.float32) * (D ** -0.5)
    qi = jnp.arange(CHUNK)[:, None] + LEFT_CHUNKS * CHUNK
    kj = jnp.arange(BAND)[None, :]
    rel = jnp.clip(qi - kj, -REL_CLIP, REL_CLIP) + REL_CLIP
    bias = rel_bias.astype(jnp.float32)[:, rel]
    key_chunk = band_idx - LEFT_CHUNKS
    valid = jnp.repeat(key_chunk >= 0, CHUNK, axis=1)
    scores = jnp.where(valid[None, :, None, None, :], scores + bias[None, None], -jnp.inf)
    p = jax.nn.softmax(scores, axis=-1).astype(v.dtype)
    o = jnp.einsum('bnhqk,bnkhd->bnqhd', p, vb)
    return o.reshape(B, S, H, D)


def hybrid_layer(x, w_in, w_out, g_pre, g_post, w_alpha, b_alpha, g_gla, g_att, rel_bias):
    B, S, _ = x.shape
    h = rmsnorm(x, g_pre)
    z = h @ w_in
    gq, gk, gv, gg, ga, aq, ak, av, ag = split_columns(z)
    log_a = jax.nn.log_sigmoid((ga @ w_alpha + b_alpha).astype(jnp.float32)) / GLA_TAU
    o_gla = gla_chunk_causal(gq.reshape(B, S, GLA_HEADS, GLA_DK),
                             gk.reshape(B, S, GLA_HEADS, GLA_DK),
                             gv.reshape(B, S, GLA_HEADS, GLA_DV),
                             log_a.reshape(B, S, GLA_HEADS, GLA_DK))
    o_gla = rmsnorm(o_gla, g_gla.reshape(GLA_HEADS, GLA_DV)).reshape(B, S, D_GLA)
    o_gla = o_gla * jax.nn.silu(gg)
    o_att = chunk_band_attention(aq.reshape(B, S, ATT_HEADS, ATT_HD),
                                 ak.reshape(B, S, ATT_HEADS, ATT_HD),
                                 av.reshape(B, S, ATT_HEADS, ATT_HD), rel_bias)
    o_att = rmsnorm(o_att, g_att.reshape(ATT_HEADS, ATT_HD)).reshape(B, S, D_ATT)
    o_att = o_att * jax.nn.silu(ag)
    y = jnp.concatenate([o_gla, o_att], axis=-1) @ w_out
    return x + rmsnorm(y, g_post)


def setup_inputs(seed: int = 0) -> dict:
    key = jax.random.key(seed)
    ks = jax.random.split(key, 10)
    x = jax.random.normal(ks[0], (BATCH, SEQ, D_MODEL), jnp.float32)
    w_in = jax.random.normal(ks[1], (DEPTH, D_MODEL, D_IN), jnp.float32) * (D_MODEL ** -0.5)
    w_out = jax.random.normal(ks[2], (DEPTH, D_MIX, D_MODEL), jnp.float32) * (D_MIX ** -0.5)
    g_pre = 1.0 + 0.02 * jax.random.normal(ks[3], (DEPTH, D_MODEL), jnp.float32)
    g_post = 1.0 + 0.02 * jax.random.normal(ks[4], (DEPTH, D_MODEL), jnp.float32)
    w_alpha = jax.random.normal(ks[5], (DEPTH, GLA_GATE_RANK, GLA_KW), jnp.float32) * (GLA_GATE_RANK ** -0.5)
    b_alpha = 0.1 * jax.random.normal(ks[6], (DEPTH, GLA_KW), jnp.float32)
    g_gla = 1.0 + 0.02 * jax.random.normal(ks[7], (DEPTH, D_GLA), jnp.float32)
    g_att = 1.0 + 0.02 * jax.random.normal(ks[8], (DEPTH, D_ATT), jnp.float32)
    rel_bias = 0.1 * jax.random.normal(ks[9], (DEPTH, ATT_HEADS, N_REL), jnp.float32)
    return {"x": x, "w_in": w_in, "w_out": w_out, "g_pre": g_pre, "g_post": g_post,
            "w_alpha": w_alpha, "b_alpha": b_alpha, "g_gla": g_gla, "g_att": g_att,
            "rel_bias": rel_bias}


def reference(x, w_in, w_out, g_pre, g_post, w_alpha, b_alpha, g_gla, g_att, rel_bias):
    h = x
    for l in range(DEPTH):
        h = hybrid_layer(h, w_in[l], w_out[l], g_pre[l], g_post[l], w_alpha[l], b_alpha[l],
                         g_gla[l], g_att[l], rel_bias[l])
    return h
```

```cpp
#include <hip/hip_runtime.h>
#include <hip/hip_cooperative_groups.h>
#include <cstdio>
namespace cg = cooperative_groups;

#define LAS __attribute__((address_space(3)))
typedef unsigned short bf16_t;
typedef short bf16x8 __attribute__((ext_vector_type(8)));
typedef float f32x4 __attribute__((ext_vector_type(4)));
typedef unsigned u32x4 __attribute__((ext_vector_type(4)));
typedef unsigned u32x2 __attribute__((ext_vector_type(2)));
typedef float f32x16 __attribute__((ext_vector_type(16)));

constexpr int DM = 2048, NTOK = 8192, SEQ = 2048, DEPTH = 4, CHUNK = 64, NCH = 32;
constexpr int D_IN = 7184;
constexpr int LDZ = 5376;
constexpr int ZGQ = 0, ZGK = 512, ZGG = 1024, ZAQ = 2048, ZAK = 3072, ZAG = 4096, ZGA = 5120;
constexpr int NVT = 2048;
constexpr float EPS = 1e-6f;
__host__ __device__ __forceinline__ constexpr size_t zaddr(int tok, int col) { return (size_t)(col >> 7) * ((size_t)8192 * 128) + (size_t)tok * 128 + (col & 127); }
__host__ __device__ __forceinline__ constexpr size_t vaddr(int d, int tok) { return (size_t)(tok >> 6) * ((size_t)2048 * 64) + (size_t)d * 64 + (tok & 63); }
constexpr int NTHR = 512, NWAVES = 8;
constexpr int LDS_BYTES = 156 * 1024;

constexpr size_t SZ_W1T = (size_t)LDZ * DM * 2, SZ_WSQ = (size_t)DM * DM * 2;
constexpr size_t WS_W1T = 0;
constexpr size_t WS_WVT = WS_W1T + DEPTH * SZ_W1T;
constexpr size_t WS_WOT = WS_WVT + DEPTH * SZ_WSQ;
constexpr size_t WS_H   = WS_WOT + DEPTH * SZ_WSQ;
constexpr size_t WS_Z1  = WS_H + (size_t)NTOK * DM * 2;
constexpr size_t WS_VT  = WS_Z1 + (size_t)NTOK * LDZ * 2;
constexpr size_t WS_MB  = WS_VT + (size_t)NVT * NTOK * 2;
constexpr size_t WS_Y   = WS_MB + (size_t)NTOK * DM * 2;
constexpr size_t WS_ORAW = WS_Y + (size_t)NTOK * DM * 4;
constexpr size_t WS_RSS = WS_ORAW + (size_t)NTOK * 1024 * 4;
constexpr size_t WS_SSY = WS_RSS;
constexpr size_t WS_SS2 = WS_RSS + (size_t)NTOK * 8 * 4;
constexpr size_t WS_PCN = WS_RSS + (size_t)NTOK * 16 * 4;
constexpr size_t WS_SSP = WS_RSS + (size_t)NTOK * 32 * 4;
constexpr size_t WS_CTR = WS_SSP + (size_t)NTOK * 16 * 4;
constexpr size_t WS_KD = WS_CTR + 4096;
constexpr size_t WS_AD = WS_KD + (size_t)512 * 8192 * 2;
constexpr size_t WS_BAR = WS_AD + (size_t)512 * 128 * 4;
constexpr size_t WS_END = WS_BAR + 3456 * 4;

typedef float f32x2 __attribute__((ext_vector_type(2)));
typedef __bf16 bf16x2_t __attribute__((ext_vector_type(2)));
__device__ __forceinline__ unsigned pk2(float lo, float hi) { const f32x2 v = {lo, hi}; const bf16x2_t r = __builtin_convertvector(v, bf16x2_t); return __builtin_bit_cast(unsigned, r); }
__device__ __forceinline__ unsigned f2bf(float f) { return pk2(f, 0.f) & 0xffffu; }
__device__ __forceinline__ float bf2f(bf16_t b) { return __uint_as_float(((unsigned)b) << 16); }
__device__ __forceinline__ float wave_sum(float v) {
#pragma unroll
    for (int o = 1; o < 64; o <<= 1) v += __shfl_xor(v, o);
    return v;
}
__device__ __forceinline__ float silu_f(float x) { return x / (1.0f + __expf(-x)); }
__device__ __forceinline__ float logsigmoid_f(float x) { return fminf(x, 0.f) - log1pf(__expf(-fabsf(x))); }
__device__ __forceinline__ float logsigmoid_fast(float x) { return fminf(x, 0.f) - __logf(1.0f + __expf(-fabsf(x))); }
__device__ __forceinline__ int opaque_tid() { int t = threadIdx.x; asm volatile("" : "+v"(t)); return t; }
#define LDS_WAIT() asm volatile("s_waitcnt lgkmcnt(0)" ::: "memory")

namespace pg8 {
#define PG8_LAS __attribute__((address_space(3)))
constexpr int BM = 256, BK = 64, HALF = 128, HTB = HALF * BK * 2, STAGE_BYTES = 8 * HTB, NXCD = 8, WGM = 2;
__host__ __device__ __forceinline__ int lds_byte(int r, int c) { const int st = (r >> 4) * 2 + (c >> 5), rr = r & 15, cc = c & 31, ob = rr * 64 + cc * 2; return st * 1024 + (ob ^ (((ob >> 9) & 1) << 5)); }
__host__ __device__ __forceinline__ void stage_rc(int b, int& R, int& C) { const int st = b / 1024, sb = b % 1024, swz = sb ^ (((sb >> 9) & 1) << 5); R = (st >> 1) * 16 + swz / 64; C = (st & 1) * 32 + (swz % 64) / 2; }
__host__ __device__ __forceinline__ int perm32(int rho) { const int n = rho >> 4, i = rho & 15; return 8 * (i >> 2) + 4 * n + (i & 3); }
struct Unit { int pm, pn, which; };
struct Gemm { const bf16_t* A; const bf16_t* Bt; int M, N, K; };
struct StaticOrder {
    int nM, nN, nwg, G, c, wgm;
    __host__ __device__ void init(int M, int N, int G_, int c_, int wgm_ = WGM) { nM = M / BM; nN = N / BM; nwg = nM * nN; G = G_; c = c_; wgm = wgm_; }
    __host__ __device__ bool next(int i, Unit& u) const { const long L = (long)i * G + c; if (L >= nwg) return false; u.which = 0; decode((int)L, u); return true; }
    __device__ __forceinline__ const bf16_t* opA(const Gemm& g, const Unit&) const { return g.A; }
    __device__ __forceinline__ const bf16_t* opB(const Gemm& g, const Unit&) const { return g.Bt; }
    __host__ __device__ void decode(int L, Unit& u) const {
        int wgid = L; { const int q = nwg / NXCD, r = nwg % NXCD, xcd = wgid % NXCD, off = wgid / NXCD; wgid = (xcd < r ? xcd * (q + 1) : r * (q + 1) + (xcd - r) * q) + off; }
        const int nig = wgm * nN, gid = wgid / nig, fm = gid * wgm, gsz = (nM - fm) < wgm ? (nM - fm) : wgm;
        u.pm = fm + ((wgid % nig) % gsz); u.pn = (wgid % nig) / gsz;
    }
    __device__ __forceinline__ void a_ready(const Unit&) const {}
    __device__ __forceinline__ void done(const Unit&) const {}
};
struct DualOrder {
    StaticOrder s0, s1; const bf16_t *A0, *B0, *A1, *B1; int G, c;
    __host__ __device__ bool next(int i, Unit& u) const { const long L = (long)i * G + c; if (L >= s0.nwg + s1.nwg) return false;
        if (L < s0.nwg) { u.which = 0; s0.decode((int)L, u); } else { u.which = 1; s1.decode((int)L - s0.nwg, u); } return true; }
    __device__ __forceinline__ const bf16_t* opA(const Gemm&, const Unit& u) const { return u.which ? A1 : A0; }
    __device__ __forceinline__ const bf16_t* opB(const Gemm&, const Unit& u) const { return u.which ? B1 : B0; }
    __device__ __forceinline__ void a_ready(const Unit&) const {}
    __device__ __forceinline__ void done(const Unit&) const {}
};
__device__ __forceinline__ unsigned cvt_pk_bf16(float lo, float hi) { return pk2(lo, hi); }

struct EpiBf16 {
    static constexpr bool PERM = true, KSCALE = false, AFTER_DRAIN = false;
    bf16_t* O; int mode_;
    const float* ss2; bf16_t* O1;
    __device__ __forceinline__ float tok_rstd(int tok) const { const f32x4 p0 = *(const f32x4*)(ss2 + (size_t)tok * 8), p1 = *(const f32x4*)(ss2 + (size_t)tok * 8 + 4);
        return rsqrtf((((p0[0] + p0[1]) + (p0[2] + p0[3])) + ((p1[0] + p1[1]) + (p1[2] + p1[3]))) * (1.0f / DM) + EPS); }
    __device__ __forceinline__ void operator()(const f32x4 (&acc)[2][2][4][2], const Unit& u, int wr, int wc, int fr, int fq) const {
        const int row0 = u.pm * BM + wr * 64 + fr; const int col0 = u.pn * BM + wc * 32 + 8 * fq;
        const int mode = mode_ < 0 ? u.which : mode_; bf16_t* const Ob = (mode_ < 0 && u.which) ? O1 : O;
        const size_t rstep = mode == 0 ? (size_t)16 * 128 : (size_t)16 * 64, hstepr = mode == 0 ? (size_t)HALF * 128 : (size_t)HALF * 64;
        const size_t cstep = mode == 0 ? (size_t)NTOK * 128 : (size_t)2 * NVT * 64;
        bf16_t* base = Ob + (mode == 0 ? zaddr(row0, col0) : vaddr(row0, col0));
#pragma unroll
        for (int ai = 0; ai < 2; ++ai)
#pragma unroll
            for (int m = 0; m < 4; ++m) { bf16_t* rowp = base + ai * hstepr + m * rstep;
#pragma unroll
                for (int bj = 0; bj < 2; ++bj) { const f32x4 v0 = acc[ai][bj][m][0], v1 = acc[ai][bj][m][1];
                    u32x4 w; w.x = cvt_pk_bf16(v0[0], v0[1]); w.y = cvt_pk_bf16(v0[2], v0[3]); w.z = cvt_pk_bf16(v1[0], v1[1]); w.w = cvt_pk_bf16(v1[2], v1[3]);
                    *(u32x4*)(rowp + bj * cstep) = w; } }
    }
};
struct EpiF32SS {
    static constexpr bool PERM = false, KSCALE = true;
    __device__ __forceinline__ void kscale(f32x4 (&acc)[2][2][4][2], int t, PG8_LAS unsigned char* lds, int wr, int fr) const {
        const PG8_LAS float* tab = (const PG8_LAS float*)(lds + 131072) + ((t >> 2) - 1) * 256 + wr * 64 + fr;
#pragma unroll
        for (int ai = 0; ai < 2; ++ai)
#pragma unroll
            for (int m = 0; m < 4; ++m) { const float r = tab[ai * HALF + m * 16];
#pragma unroll
                for (int bj = 0; bj < 2; ++bj)
#pragma unroll
                    for (int n = 0; n < 2; ++n) acc[ai][bj][m][n] *= r; }
        asm volatile("s_waitcnt lgkmcnt(0)" ::: "memory");
    }
    static constexpr bool AFTER_DRAIN = true;
    const float* ssp;
    __device__ __forceinline__ void pre(PG8_LAS unsigned char* lds, const Unit& u, int tid) const {
        if (tid < 256) { PG8_LAS float* tab = (PG8_LAS float*)(lds + 131072); float rr[4]; const f32x4* sp = (const f32x4*)(ssp + (size_t)(u.pm * BM + tid) * 16);
#pragma unroll
            for (int hq = 0; hq < 4; ++hq) { const f32x4 p4 = sp[hq]; rr[hq] = rsqrtf(((p4[0] + p4[1]) + (p4[2] + p4[3])) * (1.0f / 256.0f) + EPS); }
            tab[tid] = rr[0] / rr[1]; tab[256 + tid] = rr[1] / rr[2]; tab[512 + tid] = rr[2] / rr[3]; tab[768 + tid] = rr[3]; }
    }
    const float* xin; float* out; const float* gpost; const float* gpre; bf16_t* H; float* ssy; float* ss2; unsigned* cnt; int wantH;
    __device__ __forceinline__ void operator()(const f32x4 (&)[2][2][4][2], const Unit&, int, int, int, int) const {}
    __device__ __forceinline__ void fused(f32x4 (&acc)[2][2][4][2], const Unit& u, int wr, int wc, int fr, int fq, PG8_LAS unsigned char* lds, int tid) const {
        PG8_LAS float* P = (PG8_LAS float*)lds;
        PG8_LAS float* Srow = (PG8_LAS float*)(lds + 4096);
        const int col0 = u.pn * BM + wc * 32 + 4 * fq;
        f32x4 xa[4][4], gpo[4];
#pragma unroll
        for (int q = 0; q < 4; ++q) gpo[q] = *(const f32x4*)(gpost + col0 + (q >> 1) * HALF + (q & 1) * 16);
#pragma unroll
        for (int m = 0; m < 4; ++m)
#pragma unroll
            for (int q = 0; q < 4; ++q) xa[m][q] = *(const f32x4*)(xin + (size_t)(u.pm * BM + wr * 64 + m * 16 + fr) * DM + col0 + (q >> 1) * HALF + (q & 1) * 16);
#pragma unroll
        for (int ai = 0; ai < 2; ++ai)
#pragma unroll
            for (int m = 0; m < 4; ++m) { float s = 0.f;
#pragma unroll
                for (int bj = 0; bj < 2; ++bj)
#pragma unroll
                    for (int n = 0; n < 2; ++n) { const f32x4 x = acc[ai][bj][m][n]; s += (x[0] * x[0] + x[1] * x[1]) + (x[2] * x[2] + x[3] * x[3]); }
                s += __shfl_xor(s, 16); s += __shfl_xor(s, 32);
                if (fq == 0) P[(ai * HALF + wr * 64 + m * 16 + fr) * 4 + wc] = s; }
        asm volatile("s_waitcnt lgkmcnt(0)" ::: "memory"); __builtin_amdgcn_s_barrier(); asm volatile("" ::: "memory");
        if (tid < 256) { const f32x4 p = ((const PG8_LAS f32x4*)P)[tid];
            __hip_atomic_store(ssy + (size_t)(u.pm * BM + tid) * 8 + u.pn, (p[0] + p[1]) + (p[2] + p[3]), __ATOMIC_RELAXED, __HIP_MEMORY_SCOPE_AGENT); }
        asm volatile("s_waitcnt vmcnt(0)" ::: "memory"); __builtin_amdgcn_s_barrier(); asm volatile("" ::: "memory");
        if (tid == 0) {
            __hip_atomic_fetch_add(cnt + 16 * u.pm, 1u, __ATOMIC_RELAXED, __HIP_MEMORY_SCOPE_AGENT);
            unsigned sp = 0;
            while (__hip_atomic_load(cnt + 16 * u.pm, __ATOMIC_RELAXED, __HIP_MEMORY_SCOPE_AGENT) < 8u) { __builtin_amdgcn_s_sleep(2); if (++sp > (1u << 22)) break; }
            __builtin_amdgcn_fence(__ATOMIC_ACQUIRE, "agent");
            asm volatile("s_waitcnt vmcnt(0)" ::: "memory");
        }
        __builtin_amdgcn_s_barrier(); asm volatile("" ::: "memory");
        if (tid < 256) { const float* sl = ssy + (size_t)(u.pm * BM + tid) * 8; float t = 0.f;
#pragma unroll
            for (int q = 0; q < 8; ++q) t += __hip_atomic_load(sl + q, __ATOMIC_RELAXED, __HIP_MEMORY_SCOPE_AGENT);
            Srow[tid] = rsqrtf(t * (1.0f / DM) + EPS); }
        asm volatile("s_waitcnt lgkmcnt(0)" ::: "memory"); __builtin_amdgcn_s_barrier(); asm volatile("" ::: "memory");
#pragma unroll
        for (int ai = 0; ai < 2; ++ai)
#pragma unroll
            for (int m = 0; m < 4; ++m) { const int r = ai * HALF + wr * 64 + m * 16 + fr; const float rstd = Srow[r]; const size_t off = (size_t)(u.pm * BM + r) * DM + col0; float s2 = 0.f;
#pragma unroll
                for (int q = 0; q < 4; ++q) { const int bj = q >> 1, n = q & 1, co = bj * HALF + n * 16;
                    const f32x4 xn = xa[m][q] + acc[ai][bj][m][n] * rstd * gpo[q];
                    *(f32x4*)(out + off + co) = xn; s2 += (xn[0] * xn[0] + xn[1] * xn[1]) + (xn[2] * xn[2] + xn[3] * xn[3]);
                    acc[ai][bj][m][n] = xn; }
                if (ai == 0) {
#pragma unroll
                    for (int q = 0; q < 4; ++q) xa[m][q] = *(const f32x4*)(xin + off + (size_t)HALF * DM + (q >> 1) * HALF + (q & 1) * 16); }
                s2 += __shfl_xor(s2, 16); s2 += __shfl_xor(s2, 32);
                if (fq == 0) P[r * 4 + wc] = s2; }
        asm volatile("s_waitcnt lgkmcnt(0)" ::: "memory"); __builtin_amdgcn_s_barrier(); asm volatile("" ::: "memory");
        if (!wantH) return;
        if (tid < 256) { const f32x4 p = ((const PG8_LAS f32x4*)P)[tid];
            __hip_atomic_store(ss2 + (size_t)(u.pm * BM + tid) * 8 + u.pn, (p[0] + p[1]) + (p[2] + p[3]), __ATOMIC_RELAXED, __HIP_MEMORY_SCOPE_AGENT); }
        asm volatile("s_waitcnt vmcnt(0)" ::: "memory"); __builtin_amdgcn_s_barrier(); asm volatile("" ::: "memory");
        if (tid == 0) {
            __hip_atomic_fetch_add(cnt + 16 * u.pm + 1, 1u, __ATOMIC_RELAXED, __HIP_MEMORY_SCOPE_AGENT);
            unsigned sp = 0;
            while (__hip_atomic_load(cnt + 16 * u.pm + 1, __ATOMIC_RELAXED, __HIP_MEMORY_SCOPE_AGENT) < 8u) { __builtin_amdgcn_s_sleep(2); if (++sp > (1u << 22)) break; }
            __builtin_amdgcn_fence(__ATOMIC_ACQUIRE, "agent");
            asm volatile("s_waitcnt vmcnt(0)" ::: "memory");
        }
        __builtin_amdgcn_s_barrier(); asm volatile("" ::: "memory");
        if (tid < 256) { const float* sl = ss2 + (size_t)(u.pm * BM + tid) * 8; float t = 0.f;
#pragma unroll
            for (int q = 0; q < 8; ++q) t += __hip_atomic_load(sl + q, __ATOMIC_RELAXED, __HIP_MEMORY_SCOPE_AGENT);
            Srow[tid] = rsqrtf(t * (1.0f / DM) + EPS); }
        asm volatile("s_waitcnt lgkmcnt(0)" ::: "memory"); __builtin_amdgcn_s_barrier(); asm volatile("" ::: "memory");
#pragma unroll
        for (int ai = 0; ai < 2; ++ai)
#pragma unroll
            for (int m = 0; m < 4; ++m) { const int r = ai * HALF + wr * 64 + m * 16 + fr; const float r2 = Srow[r]; const size_t off = (size_t)(u.pm * BM + r) * DM + col0;
#pragma unroll
                for (int bj = 0; bj < 2; ++bj)
#pragma unroll
                    for (int n = 0; n < 2; ++n) { const int co = bj * HALF + n * 16; const f32x4 xn = acc[ai][bj][m][n] * r2, gp4 = *(const f32x4*)(gpre + col0 + co);
                        u32x2 w; w.x = pk2(xn[0] * gp4[0], xn[1] * gp4[1]); w.y = pk2(xn[2] * gp4[2], xn[3] * gp4[3]); *(u32x2*)(H + off + co) = w; } }
    }
};

template <class Epi, class Sched, bool ALIGN_EPI = true, bool SP2 = true>
__device__ __forceinline__ void gemm_phase(PG8_LAS unsigned char* lds, const Gemm g, const Sched& S, const Epi& E) {
    int tid_l = threadIdx.x; asm volatile("" : "+v"(tid_l));
    const int tid = tid_l, wid = __builtin_amdgcn_readfirstlane(tid >> 6), lane = tid & 63, wr = wid >> 2, wc = wid & 3, fr = lane & 15, fq = lane >> 4;
    const int K = g.K, nt = K / BK;
    unsigned voffA[2], voffB[2];
#pragma unroll
    for (int i = 0; i < 2; ++i) { int R, C; stage_rc(tid * 16 + i * 8192, R, C); const int Rb = Epi::PERM ? ((R & ~31) + perm32(R & 31)) : R;
        voffA[i] = (unsigned)(R * K + C) * 2u; voffB[i] = (unsigned)(Rb * K + C) * 2u; }
    const size_t kstep = (size_t)(BK * 2);
    const size_t hstep = (size_t)HALF * K * 2;
    const size_t tstep = 2 * hstep;
    const unsigned ldsw = (unsigned)wid * 1024u;
    const int aoff = lds_byte(wr * 64 + fr, fq * 8), boff = lds_byte(wc * 32 + fr, fq * 8);
#define PG8_SA(b, h) (((b) * 2 + (h)) * HTB)
#define PG8_SB(b, h) ((4 + (b) * 2 + (h)) * HTB)
#define PG8_STAGE(bufoff, gbase, voff) do { _Pragma("unroll") for (int _i = 0; _i < 2; ++_i) \
        __builtin_amdgcn_global_load_lds((const unsigned*)((const char*)(gbase) + (voff)[_i]), (PG8_LAS unsigned*)(lds + (bufoff) + ldsw + _i * 8192), 16, 0, 0); } while (0)
#define PG8_LDA(dst, b, h) do { _Pragma("unroll") for (int m = 0; m < 4; ++m) _Pragma("unroll") for (int k = 0; k < 2; ++k) dst[m][k] = *(const PG8_LAS bf16x8*)(lds + PG8_SA(b, h) + aoff + m * 2048 + k * 1024); } while (0)
#define PG8_LDB(dst, b, h) do { _Pragma("unroll") for (int n = 0; n < 2; ++n) _Pragma("unroll") for (int k = 0; k < 2; ++k) dst[n][k] = *(const PG8_LAS bf16x8*)(lds + PG8_SB(b, h) + boff + n * 2048 + k * 1024); } while (0)
#define PG8_MMA(ai, bj, At, Bt) do { __builtin_amdgcn_s_setprio(1); _Pragma("unroll") for (int m = 0; m < 4; ++m) _Pragma("unroll") for (int n = 0; n < 2; ++n) _Pragma("unroll") for (int k = 0; k < 2; ++k) \
        acc[ai][bj][m][n] = __builtin_amdgcn_mfma_f32_16x16x32_bf16(Bt[n][k], At[m][k], acc[ai][bj][m][n], 0, 0, 0); __builtin_amdgcn_s_setprio(0); } while (0)
#define PG8_WAIT_V(n) asm volatile("s_waitcnt vmcnt(" #n ")" ::: "memory")
#define PG8_WAIT_L(n) asm volatile("s_waitcnt lgkmcnt(" #n ")" ::: "memory")
#define PG8_BAR __builtin_amdgcn_s_barrier()
#define PG8_SCHED __builtin_amdgcn_sched_barrier(0)
    Unit cur, nxt; int ui = 0;
    if (!S.next(0, cur)) return;
    f32x4 acc[2][2][4][2];
#pragma unroll
    for (int a = 0; a < 2; ++a)
#pragma unroll
        for (int b = 0; b < 2; ++b)
#pragma unroll
            for (int m = 0; m < 4; ++m)
#pragma unroll
                for (int n = 0; n < 2; ++n) acc[a][b][m][n] = (f32x4){0.f, 0.f, 0.f, 0.f};
    bf16x8 At[4][2], B0[2][2], B1[2][2];
    const char* cA = (const char*)S.opA(g, cur) + (size_t)cur.pm * tstep; const char* cB = (const char*)S.opB(g, cur) + (size_t)cur.pn * tstep;
    S.a_ready(cur);
    if constexpr (SP2) {
        PG8_STAGE(PG8_SB(0, 0), cB, voffB); PG8_STAGE(PG8_SB(0, 1), cB + hstep, voffB); PG8_STAGE(PG8_SA(0, 0), cA, voffA); PG8_STAGE(PG8_SA(0, 1), cA + hstep, voffA);
        if constexpr (Epi::KSCALE) E.pre(lds, cur, tid);
        if (wr == 1) PG8_BAR;
        PG8_WAIT_V(2); PG8_BAR;
        PG8_STAGE(PG8_SB(1, 0), cB + kstep, voffB); PG8_STAGE(PG8_SA(1, 0), cA + kstep, voffA); PG8_STAGE(PG8_SB(1, 1), cB + hstep + kstep, voffB);
        PG8_WAIT_V(6); PG8_BAR;
    } else {
        PG8_STAGE(PG8_SB(0, 0), cB, voffB); PG8_STAGE(PG8_SA(0, 0), cA, voffA); PG8_STAGE(PG8_SB(0, 1), cB + hstep, voffB); PG8_STAGE(PG8_SA(0, 1), cA + hstep, voffA);
        if (wr == 1) PG8_BAR;
        PG8_WAIT_V(4); PG8_BAR;
        PG8_STAGE(PG8_SB(1, 0), cB + kstep, voffB); PG8_STAGE(PG8_SA(1, 0), cA + kstep, voffA); PG8_STAGE(PG8_SB(1, 1), cB + hstep + kstep, voffB);
        PG8_WAIT_V(6); PG8_BAR;
    }
    for (;;) {
        const bool has_next = S.next(ui + 1, nxt);
        const char* nA = has_next ? (const char*)S.opA(g, nxt) + (size_t)nxt.pm * tstep : cA; const char* nB = has_next ? (const char*)S.opB(g, nxt) + (size_t)nxt.pn * tstep : cB;
        for (int t = 0; t < nt; t += 2) {
            const bool last = (t == nt - 2);
            const char* a1 = cA + (size_t)(t + 1) * kstep;
            const char* a2 = last ? nA : cA + (size_t)(t + 2) * kstep; const char* b2 = last ? nB : cB + (size_t)(t + 2) * kstep;
            const char* a3 = a2 + kstep; const char* b3 = b2 + kstep;
            if (last && has_next) S.a_ready(nxt);
            if constexpr (Epi::KSCALE) { if (t >= 4 && t <= 16 && (t & 3) == 0) { E.kscale(acc, t, lds, wr, fr); PG8_SCHED; } }
            if constexpr (SP2) {
            PG8_LDB(B0, 0, 0); PG8_LDB(B1, 0, 1); PG8_SCHED; PG8_LDA(At, 0, 0); PG8_STAGE(PG8_SA(1, 1), a1 + hstep, voffA);
            PG8_WAIT_V(8); PG8_WAIT_L(0); PG8_BAR; PG8_MMA(0, 0, At, B0); PG8_MMA(0, 1, At, B1); PG8_BAR; PG8_SCHED;
            PG8_LDA(At, 0, 1); PG8_STAGE(PG8_SB(0, 0), b2, voffB); PG8_STAGE(PG8_SB(0, 1), b2 + hstep, voffB); PG8_STAGE(PG8_SA(0, 0), a2, voffA);
            PG8_WAIT_V(8); PG8_WAIT_L(0); PG8_BAR; PG8_MMA(1, 0, At, B0); PG8_MMA(1, 1, At, B1); PG8_BAR; PG8_SCHED;
            PG8_LDB(B0, 1, 0); PG8_LDB(B1, 1, 1); PG8_SCHED; PG8_LDA(At, 1, 0); PG8_STAGE(PG8_SA(0, 1), a2 + hstep, voffA);
            PG8_WAIT_V(8); PG8_WAIT_L(0); PG8_BAR; PG8_MMA(0, 0, At, B0); PG8_MMA(0, 1, At, B1); PG8_BAR; PG8_SCHED;
            PG8_LDA(At, 1, 1); PG8_STAGE(PG8_SB(1, 0), b3, voffB); PG8_STAGE(PG8_SB(1, 1), b3 + hstep, voffB); PG8_STAGE(PG8_SA(1, 0), a3, voffA);
            PG8_WAIT_V(8); PG8_WAIT_L(0); PG8_BAR; PG8_MMA(1, 0, At, B0); PG8_MMA(1, 1, At, B1); PG8_BAR; PG8_SCHED;
            } else {
            PG8_LDB(B0, 0, 0); PG8_SCHED; PG8_LDA(At, 0, 0); PG8_STAGE(PG8_SA(1, 1), a1 + hstep, voffA);
            PG8_WAIT_L(8); PG8_BAR; PG8_WAIT_L(0); PG8_MMA(0, 0, At, B0); PG8_BAR; PG8_SCHED;
            PG8_LDB(B1, 0, 1); PG8_STAGE(PG8_SB(0, 0), b2, voffB);
            PG8_BAR; PG8_WAIT_L(0); PG8_MMA(0, 1, At, B1); PG8_BAR;
            PG8_LDA(At, 0, 1); PG8_STAGE(PG8_SA(0, 0), a2, voffA);
            PG8_BAR; PG8_WAIT_L(0); PG8_MMA(1, 0, At, B0); PG8_BAR; PG8_SCHED;
            PG8_STAGE(PG8_SB(0, 1), b2 + hstep, voffB);
            PG8_WAIT_V(6); PG8_BAR; PG8_MMA(1, 1, At, B1); PG8_BAR;
            PG8_LDB(B0, 1, 0); PG8_SCHED; PG8_LDA(At, 1, 0); PG8_STAGE(PG8_SA(0, 1), a2 + hstep, voffA);
            PG8_WAIT_L(8); PG8_BAR; PG8_WAIT_L(0); PG8_MMA(0, 0, At, B0); PG8_BAR; PG8_SCHED;
            PG8_LDB(B1, 1, 1); PG8_STAGE(PG8_SB(1, 0), b3, voffB);
            PG8_BAR; PG8_WAIT_L(0); PG8_MMA(0, 1, At, B1); PG8_BAR;
            PG8_LDA(At, 1, 1); PG8_STAGE(PG8_SA(1, 0), a3, voffA);
            PG8_BAR; PG8_WAIT_L(0); PG8_MMA(1, 0, At, B0); PG8_BAR; PG8_SCHED;
            PG8_STAGE(PG8_SB(1, 1), b3 + hstep, voffB);
            PG8_WAIT_V(6); PG8_BAR; PG8_MMA(1, 1, At, B1); PG8_BAR;
            }
        }
        if constexpr (ALIGN_EPI) { if (wr == 0) PG8_BAR; }
        if constexpr (!Epi::AFTER_DRAIN) { E(acc, cur, wr, wc, fr, fq); S.done(cur); }
        if (!has_next) break;
#pragma unroll
        for (int a = 0; a < 2; ++a)
#pragma unroll
            for (int b = 0; b < 2; ++b)
#pragma unroll
                for (int m = 0; m < 4; ++m)
#pragma unroll
                    for (int n = 0; n < 2; ++n) acc[a][b][m][n] = (f32x4){0.f, 0.f, 0.f, 0.f};
        cur = nxt; cA = nA; cB = nB; ++ui;
        if constexpr (ALIGN_EPI) { if (wr == 1) PG8_BAR; }
    }
    PG8_WAIT_V(0);
    if constexpr (!ALIGN_EPI) { if (wr == 0) PG8_BAR; }
    PG8_BAR;
    if constexpr (Epi::AFTER_DRAIN) { E.fused(acc, cur, wr, wc, fr, fq, lds, tid); }
#undef PG8_SA
#undef PG8_SB
#undef PG8_STAGE
#undef PG8_LDA
#undef PG8_LDB
#undef PG8_MMA
#undef PG8_WAIT_V
#undef PG8_WAIT_L
#undef PG8_BAR
#undef PG8_SCHED
}
}

struct Args {
    const float* x; const float* w_in; const float* w_out; const float* g_pre; const float* g_post;
    const float* w_alpha; const float* b_alpha; const float* g_gla; const float* g_att; const float* rel_bias;
    float* out; unsigned char* ws;
    int ph_lo, ph_hi, coop, pad;
};

typedef const __attribute__((address_space(4))) Args* KArgs;
__device__ __forceinline__ KArgs fresh_args() { KArgs p = (KArgs)__builtin_amdgcn_kernarg_segment_ptr(); asm volatile("" : "+s"(p)); return p; }
__device__ __forceinline__ bf16_t* win_dest(int j, bf16_t* W1T, bf16_t* WVT) {
    if (j < 1024) return W1T + (size_t)j * DM;
    if (j < 2048) return WVT + (size_t)(j - 1024) * DM;
    if (j < 3072) return W1T + (size_t)(j - 1024) * DM;
    if (j < 3088) return W1T + (size_t)(ZGA + (j - 3072)) * DM;
    if (j < 4112) return W1T + (size_t)(ZAQ + (j - 3088)) * DM;
    if (j < 5136) return W1T + (size_t)(ZAK + (j - 4112)) * DM;
    if (j < 6160) return WVT + (size_t)(1024 + (j - 5136)) * DM;
    return W1T + (size_t)(ZAG + (j - 6160)) * DM;
}
template <bool IS_IN>
__device__ __forceinline__ void p0_item(const float* W, int N, LAS float* scr, int item, int lane, bf16_t* D0, bf16_t* D1) {
    const int nblk = (N + 63) / 64, kb = item / nblk, nb = item % nblk, k0 = 64 * kb, n0 = 64 * nb;
    const int n4 = (lane & 15) * 4; const bool okr = n0 + n4 < N;
    const float* wp = W + (size_t)(k0 + (lane >> 4)) * N + n0 + n4;
    f32x4 v[16];
#pragma unroll
    for (int i = 0; i < 16; ++i) v[i] = okr ? *(const f32x4*)(wp + (size_t)(4 * i) * N) : (f32x4){0.f, 0.f, 0.f, 0.f};
#pragma unroll
    for (int i = 0; i < 16; ++i) { LAS float* s = scr + (4 * i + (lane >> 4)) * 65 + n4; s[0] = v[i][0]; s[1] = v[i][1]; s[2] = v[i][2]; s[3] = v[i][3]; }
    LDS_WAIT(); asm volatile("" ::: "memory");
    const int c = lane & 7;
#pragma unroll
    for (int j = 0; j < 8; ++j) { const int n = (lane >> 3) + 8 * j; const LAS float* s = scr + (8 * c) * 65 + n;
        u32x4 o; o.x = pk2(s[0 * 65], s[1 * 65]); o.y = pk2(s[2 * 65], s[3 * 65]); o.z = pk2(s[4 * 65], s[5 * 65]); o.w = pk2(s[6 * 65], s[7 * 65]);
        const int ns = n0 + n;
        if (ns < N) { bf16_t* d = IS_IN ? win_dest(ns, D0, D1) : D0 + (size_t)ns * DM; *(u32x4*)(d + k0 + 8 * c) = o; } }
    LDS_WAIT(); asm volatile("" ::: "memory");
}

__device__ __forceinline__ void rowpass0(KArgs a) {
    const int tid = opaque_tid(), lane = tid & 63, gw = blockIdx.x * NWAVES + (tid >> 6), NGW = gridDim.x * NWAVES;
    bf16_t* H = (bf16_t*)(a->ws + WS_H);
    f32x4 nx[8];
    { const f32x4* xr = (const f32x4*)(a->x + (size_t)(gw < NTOK ? gw : 0) * DM) + lane;
#pragma unroll
      for (int j = 0; j < 8; ++j) nx[j] = xr[64 * j]; }
    for (int row = gw; row < NTOK; row += NGW) {
        f32x4 v[8];
#pragma unroll
        for (int j = 0; j < 8; ++j) v[j] = nx[j];
        { const int rn = row + NGW < NTOK ? row + NGW : row; const f32x4* xr = (const f32x4*)(a->x + (size_t)rn * DM) + lane;
#pragma unroll
          for (int j = 0; j < 8; ++j) nx[j] = xr[64 * j]; }
        float s = 0.f;
#pragma unroll
        for (int j = 0; j < 8; ++j) s += (v[j][0] * v[j][0] + v[j][1] * v[j][1]) + (v[j][2] * v[j][2] + v[j][3] * v[j][3]);
        s = wave_sum(s);
        const float r2 = rsqrtf(s * (1.0f / DM) + EPS);
        const f32x4* gq = (const f32x4*)a->g_pre + lane; u32x2* ho = (u32x2*)(H + (size_t)row * DM) + lane;
#pragma unroll
        for (int j = 0; j < 8; ++j) { const f32x4 g = gq[64 * j]; u32x2 w; w.x = pk2(v[j][0] * r2 * g[0], v[j][1] * r2 * g[1]); w.y = pk2(v[j][2] * r2 * g[2], v[j][3] * r2 * g[3]); ho[64 * j] = w; }
    }
}

__device__ __forceinline__ void convert_layer(KArgs a, int l, LAS unsigned char* lds, int wk, int nwk) {
    const int tid0 = opaque_tid(), lane = tid0 & 63, wave = __builtin_amdgcn_readfirstlane(tid0 >> 6);
    LAS float* scr = (LAS float*)(lds + wave * 16640);
    constexpr int I_IN = 32 * 113, I_OUT = 32 * 32;
    bf16_t* W1T = (bf16_t*)(a->ws + WS_W1T) + (size_t)l * LDZ * DM; bf16_t* WVT = (bf16_t*)(a->ws + WS_WVT) + (size_t)l * DM * DM; bf16_t* WOT = (bf16_t*)(a->ws + WS_WOT) + (size_t)l * DM * DM;
    for (int r = wk; r < I_IN + I_OUT; r += nwk) {
        if (r < I_IN) p0_item<true>(a->w_in + (size_t)l * DM * D_IN, D_IN, scr, r, lane, W1T, WVT);
        else p0_item<false>(a->w_out + (size_t)l * DM * DM, DM, scr, r - I_IN, lane, WOT, nullptr);
    }
}
__device__ __forceinline__ void p0_phase(KArgs a, LAS unsigned char* lds) {
    const int tid0 = opaque_tid(), lane = tid0 & 63, wave = __builtin_amdgcn_readfirstlane(tid0 >> 6);
    LAS float* scr = (LAS float*)(lds + wave * 16640);
    const int gw = blockIdx.x * NWAVES + wave, NGW = gridDim.x * NWAVES;
    constexpr int I_IN = 32 * 113, I_OUT = 32 * 32, NITEMS = DEPTH * (I_IN + I_OUT);
    bf16_t* W1T = (bf16_t*)(a->ws + WS_W1T); bf16_t* WVT = (bf16_t*)(a->ws + WS_WVT); bf16_t* WOT = (bf16_t*)(a->ws + WS_WOT);
    convert_layer(a, 0, lds, gw, NGW);
    { const int tid = blockIdx.x * NTHR + tid0, NT = gridDim.x * NTHR; constexpr int PADV = 240 * DM / 8;
      for (int i = tid; i < DEPTH * PADV; i += NT) { const int l = i / PADV, r = i % PADV; *((u32x4*)(W1T + (size_t)l * LDZ * DM + (size_t)(ZGA + 16) * DM) + r) = (u32x4){0u, 0u, 0u, 0u}; }
    }
    if (blockIdx.x == 0) { for (int i = tid0; i < 1024; i += NTHR) ((unsigned*)(a->ws + WS_CTR))[i] = 0u; }
    if (blockIdx.x == 1) { for (int i = tid0; i < (DEPTH * 32 + 2 * DEPTH) * 16; i += NTHR) ((unsigned*)(a->ws + WS_PCN))[i] = 0u; }
    rowpass0(a);
}

__device__ __forceinline__ void attn_naive_item(KArgs a, int l, int item) {
    const int tid = opaque_tid();
    const bf16_t* Z = (const bf16_t*)(a->ws + WS_Z1); const bf16_t* VT = (const bf16_t*)(a->ws + WS_VT); bf16_t* MB = (bf16_t*)(a->ws + WS_MB);
    const int h = item & 7, c = (item >> 3) & 31, b = item >> 8;
    const int qi = tid >> 3, dp = tid & 7;
    const int tokq = b * SEQ + c * CHUNK + qi;
    const float* rb = a->rel_bias + ((size_t)l * 8 + h) * 257;
    float q[16], acc[16];
#pragma unroll
    for (int i = 0; i < 16; ++i) { q[i] = bf2f(Z[(size_t)tokq * LDZ + ZAQ + h * 128 + dp * 16 + i]); acc[i] = 0.f; }
    float mx = -1e30f, ls = 0.f;
    const int kc0 = c - 8 < 0 ? 0 : c - 8;
    for (int kc = kc0; kc <= c; ++kc)
        for (int j = 0; j < CHUNK; ++j) {
            const int tokk = b * SEQ + kc * CHUNK + j;
            const bf16_t* kr = Z + (size_t)tokk * LDZ + ZAK + h * 128 + dp * 16;
            float s = 0.f;
#pragma unroll
            for (int i = 0; i < 16; ++i) s += q[i] * bf2f(kr[i]);
            s += __shfl_xor(s, 1); s += __shfl_xor(s, 2); s += __shfl_xor(s, 4);
            int rel = (c - kc) * CHUNK + qi - j; rel = rel > 128 ? 128 : (rel < -128 ? -128 : rel);
            s = s * 0.08838834764831845f + rb[rel + 128];
            const float mn = fmaxf(mx, s), corr = __expf(mx - mn), p = __expf(s - mn);
            ls = ls * corr + p; mx = mn;
#pragma unroll
            for (int i = 0; i < 16; ++i) acc[i] = acc[i] * corr + p * bf2f(VT[(size_t)(1024 + h * 128 + dp * 16 + i) * NTOK + tokk]);
        }
    float ss = 0.f; const float inv = 1.0f / ls;
#pragma unroll
    for (int i = 0; i < 16; ++i) { acc[i] *= inv; ss += acc[i] * acc[i]; }
    ss += __shfl_xor(ss, 1); ss += __shfl_xor(ss, 2); ss += __shfl_xor(ss, 4);
    const float rstd = rsqrtf(ss * (1.0f / 128.0f) + EPS);
#pragma unroll
    for (int i = 0; i < 16; ++i) { const int d = h * 128 + dp * 16 + i;
        const float g = a->g_att[(size_t)l * 1024 + d], gate = bf2f(Z[(size_t)tokq * LDZ + ZAG + d]);
        MB[(size_t)tokq * DM + 1024 + d] = (bf16_t)f2bf(acc[i] * rstd * g * silu_f(gate)); }
}
__device__ __forceinline__ void gla_naive_item(KArgs a, int l, int item, LAS unsigned char* lds) {
    const int tid = opaque_tid();
    const bf16_t* Z = (const bf16_t*)(a->ws + WS_Z1); const bf16_t* VT = (const bf16_t*)(a->ws + WS_VT); float* OR = (float*)(a->ws + WS_ORAW);
    LAS float* L = (LAS float*)lds;
    LAS float* S = L + 64 * 128;
    const int vt = item & 15, h = (item >> 4) & 3, b = item >> 6;
    for (int i = tid; i < 128 * 16; i += NTHR) S[i] = 0.f;
    float wal[16]; float bal = 0.f;
    if (tid < 128) { for (int r = 0; r < 16; ++r) wal[r] = a->w_alpha[((size_t)l * 16 + r) * 512 + h * 128 + tid]; bal = a->b_alpha[(size_t)l * 512 + h * 128 + tid]; }
    __syncthreads();
    for (int c = 0; c < NCH; ++c) {
        const int tok0 = b * SEQ + c * CHUNK;
        if (tid < 128) { float cum = 0.f;
            for (int s = 0; s < CHUNK; ++s) { const bf16_t* gr = Z + (size_t)(tok0 + s) * LDZ + ZGA; float x = bal;
#pragma unroll
                for (int r = 0; r < 16; ++r) x += bf2f(gr[r]) * wal[r];
                cum += logsigmoid_f(x) * (1.0f / 16.0f); L[s * 128 + tid] = cum; } }
        __syncthreads();
        { const int k = tid & 127, vq = tid >> 7; const float Le = L[63 * 128 + k], Ae = __expf(Le);
          float acc[4];
#pragma unroll
          for (int i = 0; i < 4; ++i) acc[i] = S[k * 16 + vq * 4 + i] * Ae;
          for (int s = 0; s < CHUNK; ++s) { const float kd = bf2f(Z[(size_t)(tok0 + s) * LDZ + ZGK + h * 128 + k]) * __expf(Le - L[s * 128 + k]);
#pragma unroll
              for (int i = 0; i < 4; ++i) acc[i] += kd * bf2f(VT[(size_t)(h * 256 + vt * 16 + vq * 4 + i) * NTOK + tok0 + s]); }
#pragma unroll
          for (int i = 0; i < 4; ++i) S[k * 16 + vq * 4 + i] = acc[i]; }
        __syncthreads();
        { const int s = tid >> 3, v2 = (tid & 7) * 2; float o0 = 0.f, o1 = 0.f; const bf16_t* qr = Z + (size_t)(tok0 + s) * LDZ + ZGQ + h * 128;
          for (int k = 0; k < 128; ++k) { const float qv = bf2f(qr[k]); o0 += qv * S[k * 16 + v2]; o1 += qv * S[k * 16 + v2 + 1]; }
          float* op = OR + (size_t)(tok0 + s) * 1024 + h * 256 + vt * 16 + v2; op[0] = o0 * 0.08838834764831845f; op[1] = o1 * 0.08838834764831845f; }
        __syncthreads();
    }
}
__device__ __forceinline__ void gla_norm_phase(KArgs a, int l) {
    const int tid = opaque_tid(), lane = tid & 63, gw = blockIdx.x * NWAVES + (tid >> 6), NGW = gridDim.x * NWAVES;
    const bf16_t* Z = (const bf16_t*)(a->ws + WS_Z1); const float* OR = (const float*)(a->ws + WS_ORAW); bf16_t* MB = (bf16_t*)(a->ws + WS_MB);
    for (int it = gw; it < NTOK * 4; it += NGW) { const int tok = it >> 2, h = it & 3;
        const f32x4 o = *((const f32x4*)(OR + (size_t)tok * 1024 + h * 256) + lane);
        const float ss = wave_sum((o[0] * o[0] + o[1] * o[1]) + (o[2] * o[2] + o[3] * o[3]));
        const float rstd = rsqrtf(ss * (1.0f / 256.0f) + EPS);
        const f32x4 g = *((const f32x4*)(a->g_gla + (size_t)l * 1024 + h * 256) + lane);
        const bf16_t* gg = Z + (size_t)tok * LDZ + ZGG + h * 256 + lane * 4;
        u32x2 w; w.x = pk2(o[0] * rstd * g[0] * silu_f(bf2f(gg[0])), o[1] * rstd * g[1] * silu_f(bf2f(gg[1])));
        w.y = pk2(o[2] * rstd * g[2] * silu_f(bf2f(gg[2])), o[3] * rstd * g[3] * silu_f(bf2f(gg[3])));
        *((u32x2*)(MB + (size_t)tok * DM + h * 256) + lane) = w; }
}


constexpr int AT_KS = 0, AT_VS = 34816, AT_PS = 71680, AT_BIAS = 90112;
__device__ __forceinline__ void attn_item(KArgs a, int l, int item, LAS unsigned char* lds) {
    const int tid = opaque_tid();
    const bf16_t* Z = (const bf16_t*)(a->ws + WS_Z1); const bf16_t* VT = (const bf16_t*)(a->ws + WS_VT); bf16_t* MB = (bf16_t*)(a->ws + WS_MB);
    const int hp = item & 3, c = (item >> 2) & 31, b = item >> 7;
    const int lane = tid & 63, w = __builtin_amdgcn_readfirstlane(tid >> 6), hh = w >> 2, wq = w & 3, h = 2 * hp + hh;
    const int l15 = lane & 15, lg = lane >> 4;
    const int tq0 = b * SEQ + c * CHUNK;
    bf16x8 qf[4];
    { const bf16_t* qp = Z + zaddr(tq0 + wq * 16 + l15, ZAQ + h * 128 + 8 * lg);
#pragma unroll
      for (int j = 0; j < 4; ++j) qf[j] = *(const bf16x8*)(qp + 32 * j); }
    f32x4 o[8]; float mrow = -1e30f, lsum = 0.f;
#pragma unroll
    for (int i = 0; i < 8; ++i) o[i] = (f32x4){0.f, 0.f, 0.f, 0.f};
    const int kc0 = c - 8 < 0 ? 0 : c - 8;
    const bf16_t* kg = Z + zaddr(b * SEQ + (tid >> 5), ZAK + 2 * hp * 128 + (tid & 31) * 8);
    const bf16_t* vg = VT + vaddr(1024 + 2 * hp * 128 + (tid >> 3), b * SEQ + (tid & 7) * 8);
    const int kl = AT_KS + ((((tid & 31) >> 4) * 64 + (tid >> 5)) * 136 + ((tid & 31) & 15) * 8) * 2;
    const int vl = AT_VS + ((tid >> 3) * 72 + (tid & 7) * 8) * 2;
    u32x4 kreg[4], vreg[4];
#pragma unroll
    for (int i = 0; i < 4; ++i) { kreg[i] = *(const u32x4*)(kg + (size_t)(kc0 * CHUNK + 16 * i) * 128); vreg[i] = *(const u32x4*)(vg + (size_t)(64 * i) * 64 + (size_t)kc0 * NVT * 64); }
    const LAS float* bt = (const LAS float*)(lds + AT_BIAS) + hh * 260;
    constexpr float SC2 = 0.08838834764831845f * 1.4426950408889634f;
    const int qi = wq * 16 + l15;
    for (int kc = kc0; kc <= c; ++kc) {
        __syncthreads();
#pragma unroll
        for (int i = 0; i < 4; ++i) { *(LAS u32x4*)(lds + kl + i * 16 * 136 * 2) = kreg[i]; *(LAS u32x4*)(lds + vl + i * 64 * 72 * 2) = vreg[i]; }
        if (kc == kc0) { for (int i = tid; i < 2 * 257; i += NTHR) { const int hb = i / 257, r = i % 257; ((LAS float*)(lds + AT_BIAS))[hb * 260 + r] = a->rel_bias[((size_t)l * 8 + 2 * hp + hb) * 257 + r] * 1.4426950408889634f; } }
        __syncthreads();
        if (kc < c) {
#pragma unroll
            for (int i = 0; i < 4; ++i) { kreg[i] = *(const u32x4*)(kg + (size_t)((kc + 1) * CHUNK + 16 * i) * 128); vreg[i] = *(const u32x4*)(vg + (size_t)(64 * i) * 64 + (size_t)(kc + 1) * NVT * 64); }
        }
        f32x4 s[4];
        { const LAS unsigned char* kb_ = lds + AT_KS + ((hh * 64 + l15) * 136 + 8 * lg) * 2;
#pragma unroll
          for (int nh = 0; nh < 2; ++nh) { bf16x8 kf[2][4];
#pragma unroll
              for (int n2 = 0; n2 < 2; ++n2)
#pragma unroll
                  for (int j = 0; j < 4; ++j) kf[n2][j] = *(const LAS bf16x8*)(kb_ + (2 * nh + n2) * (16 * 136 * 2) + 64 * j);
              __builtin_amdgcn_sched_barrier(0);
#pragma unroll
              for (int n2 = 0; n2 < 2; ++n2) { f32x4 acc_ = (f32x4){0.f, 0.f, 0.f, 0.f};
#pragma unroll
                  for (int j = 0; j < 4; ++j) acc_ = __builtin_amdgcn_mfma_f32_16x16x32_bf16(kf[n2][j], qf[j], acc_, 0, 0, 0);
                  s[2 * nh + n2] = acc_; }
              __builtin_amdgcn_sched_barrier(0); } }
        float mloc = -1e30f;
        if (c - kc >= 3) {
            const float bc = bt[256];
#pragma unroll
            for (int n = 0; n < 4; ++n)
#pragma unroll
                for (int r = 0; r < 4; ++r) { s[n][r] = s[n][r] * SC2 + bc; mloc = fmaxf(mloc, s[n][r]); }
        } else {
            const int relbase = (c - kc) * CHUNK + qi - 4 * lg;
#pragma unroll
            for (int n = 0; n < 4; ++n)
#pragma unroll
                for (int r = 0; r < 4; ++r) { int rel = relbase - 16 * n - r; rel = rel > 128 ? 128 : (rel < -128 ? -128 : rel);
                    s[n][r] = s[n][r] * SC2 + bt[rel + 128]; mloc = fmaxf(mloc, s[n][r]); }
        }
        mloc = fmaxf(mloc, __shfl_xor(mloc, 16)); mloc = fmaxf(mloc, __shfl_xor(mloc, 32));
        const float mn = fmaxf(mrow, mloc), corr = __builtin_amdgcn_exp2f(mrow - mn); mrow = mn; lsum *= corr;
        bf16x8 pf[2];
#pragma unroll
        for (int t = 0; t < 2; ++t) { float pv[8];
#pragma unroll
            for (int e = 0; e < 8; ++e) { pv[e] = __builtin_amdgcn_exp2f(s[2 * t + (e >> 2)][e & 3] - mrow); lsum += pv[e]; }
            const u32x4 pw4 = (u32x4){pk2(pv[0], pv[1]), pk2(pv[2], pv[3]), pk2(pv[4], pv[5]), pk2(pv[6], pv[7])};
            pf[t] = __builtin_bit_cast(bf16x8, pw4); }
#pragma unroll
        for (int nd = 0; nd < 8; ++nd) o[nd] *= corr;
        { const LAS unsigned char* vb_ = lds + AT_VS + ((hh * 128 + l15) * 72 + 4 * lg) * 2;
#pragma unroll
          for (int nq = 0; nq < 2; ++nq) { u32x4 vv[4][2];
#pragma unroll
              for (int n4 = 0; n4 < 4; ++n4)
#pragma unroll
                  for (int t = 0; t < 2; ++t) { const LAS unsigned char* vp_ = vb_ + (4 * nq + n4) * (16 * 72 * 2) + 64 * t;
                      const u32x2 va = *(const LAS u32x2*)vp_, vb = *(const LAS u32x2*)(vp_ + 32); vv[n4][t] = (u32x4){va.x, va.y, vb.x, vb.y}; }
              __builtin_amdgcn_sched_barrier(0);
#pragma unroll
              for (int n4 = 0; n4 < 4; ++n4)
#pragma unroll
                  for (int t = 0; t < 2; ++t) o[4 * nq + n4] = __builtin_amdgcn_mfma_f32_16x16x32_bf16(__builtin_bit_cast(bf16x8, vv[n4][t]), pf[t], o[4 * nq + n4], 0, 0, 0);
              __builtin_amdgcn_sched_barrier(0); } }
    }
    float lt = lsum; lt += __shfl_xor(lt, 16); lt += __shfl_xor(lt, 32);
    const float inv = 1.0f / lt; float ss = 0.f;
#pragma unroll
    for (int nd = 0; nd < 8; ++nd)
#pragma unroll
        for (int r = 0; r < 4; ++r) { o[nd][r] *= inv; ss += o[nd][r] * o[nd][r]; }
    ss += __shfl_xor(ss, 16); ss += __shfl_xor(ss, 32);
    const float rstd = rsqrtf(ss * (1.0f / 128.0f) + EPS); const int tok = tq0 + qi;
#pragma unroll
    for (int nd = 0; nd < 8; ++nd) { const int d = h * 128 + 16 * nd + 4 * lg;
        const f32x4 g = *(const f32x4*)(a->g_att + (size_t)l * 1024 + d); const u32x2 gw = *(const u32x2*)(Z + zaddr(tok, ZAG + d));
        const float g0 = __uint_as_float(gw.x << 16), g1 = __uint_as_float(gw.x & 0xffff0000u), g2 = __uint_as_float(gw.y << 16), g3 = __uint_as_float(gw.y & 0xffff0000u);
        u32x2 ow; ow.x = pk2(o[nd][0] * rstd * g[0] * silu_f(g0), o[nd][1] * rstd * g[1] * silu_f(g1)); ow.y = pk2(o[nd][2] * rstd * g[2] * silu_f(g2), o[nd][3] * rstd * g[3] * silu_f(g3));
        *(u32x2*)(MB + (size_t)tok * DM + 1024 + d) = ow; }
}

constexpr int GL_GA = 0, GL_TOT = 4096, GL_ST = 8192, GL_O = 8192 + 17408;
__device__ __forceinline__ void gla_prep_item(KArgs a, int l, int item, LAS unsigned char* lds) {
    const int tid = opaque_tid();
    const bf16_t* Z = (const bf16_t*)(a->ws + WS_Z1); bf16_t* KD = (bf16_t*)(a->ws + WS_KD) + (size_t)item * 8192; float* AD = (float*)(a->ws + WS_AD) + (size_t)item * 128;
    const int c = item & 31, h = (item >> 5) & 3, b = item >> 7;
    const int pk = tid & 127, sq = tid >> 7, tok0 = b * SEQ + c * CHUNK;
    float wal[16];
#pragma unroll
    for (int r = 0; r < 16; ++r) wal[r] = a->w_alpha[((size_t)l * 16 + r) * 512 + h * 128 + pk];
    const float bal = a->b_alpha[(size_t)l * 512 + h * 128 + pk];
    const unsigned ga2 = *(const unsigned*)(Z + zaddr(tok0 + (tid >> 3), ZGA + (tid & 7) * 2));
    bf16_t kv[16];
#pragma unroll
    for (int i = 0; i < 16; ++i) kv[i] = Z[zaddr(tok0 + 16 * sq + i, ZGK + h * 128 + pk)];
    LAS float* gaS = (LAS float*)(lds + GL_GA); LAS float* tot = (LAS float*)(lds + GL_TOT);
    __syncthreads();
    gaS[(tid >> 3) * 16 + (tid & 7) * 2] = __uint_as_float(ga2 << 16); gaS[(tid >> 3) * 16 + (tid & 7) * 2 + 1] = __uint_as_float(ga2 & 0xffff0000u);
    __syncthreads();
    float Lloc[16]; float cum = 0.f;
#pragma unroll
    for (int i = 0; i < 16; ++i) { const LAS f32x4* gr = (const LAS f32x4*)(gaS + (16 * sq + i) * 16); float x = bal;
#pragma unroll
        for (int r4 = 0; r4 < 4; ++r4) { const f32x4 g4 = gr[r4]; x += g4[0] * wal[4 * r4] + g4[1] * wal[4 * r4 + 1] + g4[2] * wal[4 * r4 + 2] + g4[3] * wal[4 * r4 + 3]; }
        cum += logsigmoid_fast(x) * (1.0f / 16.0f); Lloc[i] = cum; }
    tot[sq * 128 + pk] = cum;
    __syncthreads();
    float off = 0.f, Lend = 0.f;
#pragma unroll
    for (int q = 0; q < 4; ++q) { const float t = tot[q * 128 + pk]; off += (q < sq) ? t : 0.f; Lend += t; }
    unsigned wd[8];
#pragma unroll
    for (int i = 0; i < 8; ++i) wd[i] = pk2(bf2f(kv[2 * i]) * __expf(Lend - (off + Lloc[2 * i])), bf2f(kv[2 * i + 1]) * __expf(Lend - (off + Lloc[2 * i + 1])));
    *(u32x4*)(KD + pk * 64 + 16 * sq) = (u32x4){wd[0], wd[1], wd[2], wd[3]};
    *(u32x4*)(KD + pk * 64 + 16 * sq + 8) = (u32x4){wd[4], wd[5], wd[6], wd[7]};
    if (sq == 0) AD[pk] = __expf(Lend);
}
struct GlaK { u32x4 k0, k1, v0; };
struct GlaQ { bf16x8 qf[4]; };
constexpr int GL_ADT = 8192;
constexpr int GL_ST0 = GL_ADT + 16384, GL_STB = 17408;
constexpr int GL_O0 = GL_ST0 + 2 * GL_STB, GL_OB = 16640; constexpr int GL_KV0 = GL_O0 + 2 * GL_OB, GL_KVB = 27648;
__device__ __forceinline__ float fast_silu(float x) { return x * __builtin_amdgcn_rcpf(1.0f + __expf(-x)); }
__device__ __forceinline__ void gla_chain(KArgs a, int l, int item, LAS unsigned char* lds) {
    const int tid = opaque_tid(), lane = tid & 63, w = __builtin_amdgcn_readfirstlane(tid >> 6);
    const bf16_t* Z = (const bf16_t*)(a->ws + WS_Z1); const bf16_t* VT = (const bf16_t*)(a->ws + WS_VT); bf16_t* MB = (bf16_t*)(a->ws + WS_MB); float* SSP = (float*)(a->ws + WS_SSP);
    const int j = item & 3, h = (item >> 2) & 3, b = item >> 4;
    const int kt = w >> 1, vt = w & 1, l31 = lane & 31, lh = lane >> 5;
    const int sti = w & 3, vh = w >> 2, l15 = lane & 15, lg = lane >> 4;
    const int es = tid >> 3, evq = tid & 7;
    const bf16_t* kp = (const bf16_t*)(a->ws + WS_KD) + (size_t)((b * 4 + h) * 32) * 8192 + (tid >> 3) * 64 + (tid & 7) * 8;
    const bf16_t* vp = VT + vaddr(h * 256 + 64 * j + (tid >> 3), b * SEQ + (tid & 7) * 8);
    const int kvw = ((tid >> 3) * 72 + (tid & 7) * 8) * 2;
    const int kur = ((32 * kt + l31) * 72 + 8 * lh) * 2, vur = 18432 + ((32 * vt + l31) * 72 + 8 * lh) * 2;
    const bf16_t* qp = Z + zaddr(b * SEQ + 16 * sti + l15, ZGQ + h * 128 + 8 * lg);
    const bf16_t* gp = Z + zaddr(b * SEQ + es, ZGG + h * 256 + 64 * j + 8 * evq);
    bf16_t* mp = MB + (size_t)(b * SEQ + es) * DM + h * 256 + 64 * j + 8 * evq;
    float* sp = SSP + ((size_t)(b * SEQ + es) * 4 + h) * 4 + j;
#define GLA_LDK(dst) do { (dst).k0 = *(const u32x4*)kp; (dst).k1 = *(const u32x4*)(kp + 64 * 64); (dst).v0 = *(const u32x4*)vp; kp += 8192; vp += (size_t)NVT * 64; } while (0)
#define GLA_STK(src, buf) do { LAS unsigned char* kb_ = lds + GL_KV0 + (buf) * GL_KVB + kvw; asm volatile("" : "+v"(kb_)); \
        *(LAS u32x4*)kb_ = (src).k0; *(LAS u32x4*)(kb_ + 64 * 72 * 2) = (src).k1; *(LAS u32x4*)(kb_ + 18432) = (src).v0; } while (0)
#define GLA_LDQ(dst) do { _Pragma("unroll") for (int i_ = 0; i_ < 4; ++i_) (dst).qf[i_] = *(const bf16x8*)(qp + 32 * i_); qp += (size_t)CHUNK * 128; } while (0)
    GlaK K0, K1, K2; GlaQ Q0, Q1, Q2; u32x4 G0, G1, G2;
    GLA_LDK(K0); GLA_LDK(K1); GLA_LDK(K2); GLA_LDQ(Q0);
    G0 = G1 = G2 = (u32x4){0u, 0u, 0u, 0u}; Q1 = Q0; Q2 = Q0;
    GLA_STK(K0, 0); GLA_LDK(K0);
    float gl[8];
    { const f32x4* gg4 = (const f32x4*)(a->g_gla + (size_t)l * 1024 + h * 256 + 64 * j + 8 * evq); const f32x4 ga_ = gg4[0], gb_ = gg4[1];
      gl[0] = ga_[0]; gl[1] = ga_[1]; gl[2] = ga_[2]; gl[3] = ga_[3]; gl[4] = gb_[0]; gl[5] = gb_[1]; gl[6] = gb_[2]; gl[7] = gb_[3]; }
    { const f32x4* adg = (const f32x4*)((const float*)(a->ws + WS_AD) + (size_t)((b * 4 + h) * 32) * 128); LAS f32x4* adl = (LAS f32x4*)(lds + GL_ADT);
      adl[tid] = adg[tid]; adl[tid + 512] = adg[tid + 512]; }
    f32x16 S;
#pragma unroll
    for (int i = 0; i < 16; ++i) S[i] = 0.f;
    __syncthreads();
#define GLA_ITER(i, DO_LD, DO_U, DO_O, DO_E, KU, KL, QU, QL, GU, GL_) do { const int i_t = (i); \
        if (DO_LD) { GLA_STK(KL, (i_t + 1) & 1); GLA_LDK(KL); GLA_LDQ(QL); GL_ = *(const u32x4*)gp; gp += (size_t)CHUNK * 128; }     \
        if (DO_U) {                                                                          \
            _Pragma("unroll") for (int rg = 0; rg < 4; ++rg) { const f32x4 ad = *(const LAS f32x4*)(lds + GL_ADT + (i_t * 128 + 32 * kt + 8 * rg + 4 * lh) * 4); \
                _Pragma("unroll") for (int q_ = 0; q_ < 4; ++q_) S[4 * rg + q_] *= ad[q_]; } \
            { LAS unsigned char* kvb_ = lds + GL_KV0 + (i_t & 1) * GL_KVB; asm volatile("" : "+v"(kvb_)); bf16x8 kf_[4], vf_[4]; \
              _Pragma("unroll") for (int ss = 0; ss < 4; ++ss) { kf_[ss] = *(const LAS bf16x8*)(kvb_ + kur + 32 * ss); vf_[ss] = *(const LAS bf16x8*)(kvb_ + vur + 32 * ss); } \
              _Pragma("unroll") for (int ss = 0; ss < 4; ++ss) S = __builtin_amdgcn_mfma_f32_32x32x16_bf16(kf_[ss], vf_[ss], S, 0, 0, 0); } \
            LAS unsigned char* sw_ = lds + GL_ST0 + (i_t & 1) * GL_STB + ((32 * vt + l31) * 136 + 32 * kt + 4 * lh) * 2; asm volatile("" : "+v"(sw_));     \
            _Pragma("unroll") for (int rg = 0; rg < 4; ++rg) { u32x2 wv; wv.x = pg8::cvt_pk_bf16(S[4 * rg], S[4 * rg + 1]); wv.y = pg8::cvt_pk_bf16(S[4 * rg + 2], S[4 * rg + 3]); \
                *(LAS u32x2*)(sw_ + 16 * rg) = wv; } } \
        if (DO_O) {                                                                          \
            f32x4 oa[2] = {(f32x4){0.f, 0.f, 0.f, 0.f}, (f32x4){0.f, 0.f, 0.f, 0.f}}; \
            LAS unsigned char* sr_ = lds + GL_ST0 + ((i_t - 1) & 1) * GL_STB + ((32 * vh + l15) * 136 + 8 * lg) * 2; asm volatile("" : "+v"(sr_)); \
            bf16x8 bfr[4][2]; \
            _Pragma("unroll") for (int kk = 0; kk < 4; ++kk) \
                _Pragma("unroll") for (int t = 0; t < 2; ++t) bfr[kk][t] = *(const LAS bf16x8*)(sr_ + t * (16 * 136 * 2) + kk * 64); \
            __builtin_amdgcn_sched_barrier(0);                                               \
            _Pragma("unroll") for (int kk = 0; kk < 4; ++kk) \
                _Pragma("unroll") for (int t = 0; t < 2; ++t) oa[t] = __builtin_amdgcn_mfma_f32_16x16x32_bf16((QU).qf[kk], bfr[kk][t], oa[t], 0, 0, 0); \
            LAS float* oS_ = (LAS float*)(lds + GL_O0 + ((i_t - 1) & 1) * GL_OB) + (16 * sti + 4 * lg) * 65 + 32 * vh + l15; asm volatile("" : "+v"(oS_)); \
            _Pragma("unroll") for (int t = 0; t < 2; ++t) \
                _Pragma("unroll") for (int r = 0; r < 4; ++r) oS_[r * 65 + 16 * t] = oa[t][r] * 0.08838834764831845f; } \
        if (DO_E) {                                                                          \
            const LAS float* oS_ = (const LAS float*)(lds + GL_O0 + (i_t & 1) * GL_OB) + es * 65 + 8 * evq; asm volatile("" : "+v"(oS_)); float ov[8]; float ss = 0.f; \
            _Pragma("unroll") for (int q_ = 0; q_ < 8; ++q_) { ov[q_] = oS_[q_]; ss += ov[q_] * ov[q_]; } \
            ss += __builtin_bit_cast(float, __builtin_amdgcn_mov_dpp(__builtin_bit_cast(int, ss), 0xB1, 0xF, 0xF, true));      \
            ss += __builtin_bit_cast(float, __builtin_amdgcn_mov_dpp(__builtin_bit_cast(int, ss), 0x4E, 0xF, 0xF, true));      \
            ss += __builtin_bit_cast(float, __builtin_amdgcn_mov_dpp(__builtin_bit_cast(int, ss), 0x141, 0xF, 0xF, true));     \
            if (evq == 0) *sp = ss; sp += CHUNK * 16; \
            const unsigned gw4[4] = {(GU).x, (GU).y, (GU).z, (GU).w}; unsigned ow[4]; \
            _Pragma("unroll") for (int q_ = 0; q_ < 4; ++q_) { const float g0 = __uint_as_float(gw4[q_] << 16), g1 = __uint_as_float(gw4[q_] & 0xffff0000u); \
                ow[q_] = pg8::cvt_pk_bf16(ov[2 * q_] * gl[2 * q_] * fast_silu(g0), ov[2 * q_ + 1] * gl[2 * q_ + 1] * fast_silu(g1)); } \
            *(u32x4*)mp = (u32x4){ow[0], ow[1], ow[2], ow[3]}; mp += (size_t)CHUNK * DM; } \
        asm volatile("s_waitcnt lgkmcnt(0)" ::: "memory"); __builtin_amdgcn_s_barrier(); asm volatile("" ::: "memory"); \
    } while (0)
    GLA_ITER(0, true, true, false, false, K0, K1, Q2, Q1, G1, G0); GLA_ITER(1, true, true, true, false, K1, K2, Q0, Q2, G2, G1);
#pragma nounroll
    for (int i = 2; i < 32; i += 3) { GLA_ITER(i, true, true, true, true, K2, K0, Q1, Q0, G0, G2); GLA_ITER(i + 1, true, true, true, true, K0, K1, Q2, Q1, G1, G0); GLA_ITER(i + 2, true, true, true, true, K1, K2, Q0, Q2, G2, G1); }
    GLA_ITER(32, false, false, true, true, K2, K1, Q1, Q0, G0, G2); GLA_ITER(33, false, false, false, true, K0, K2, Q2, Q1, G1, G0);
    __syncthreads();
#undef GLA_ITER
#undef GLA_LDK
#undef GLA_LDQ
}

#define XB_TMO      128
#define XB_XCNT(j)  (256  + 64 * (j))
#define XB_XSUB(j)  (1280 + 64 * (j))
#define XB_XGEN(j)  (2304 + 64 * (j))
#define XB_TOP      3328
#define XB_TOPGEN   3392
#define XCD_BAR_WORDS 3456
#define XB_SPIN_CAP (1u << 18)
__device__ __forceinline__ unsigned xb_ld(unsigned* p)              { return __hip_atomic_load(p, __ATOMIC_RELAXED, __HIP_MEMORY_SCOPE_AGENT); }
__device__ __forceinline__ unsigned xb_add(unsigned* p, unsigned v) { return __hip_atomic_fetch_add(p, v, __ATOMIC_RELAXED, __HIP_MEMORY_SCOPE_AGENT); }
__device__ __forceinline__ unsigned xb_xcc_id() { return (unsigned)__builtin_amdgcn_s_getreg((3 << 11) | 20) & 0xFu; }
#define XB_SPIN(cond, bar) do { unsigned _sp = 0; while (cond) { __builtin_amdgcn_s_sleep(1); \
    if ((++_sp & 255u) == 0u) { if (xb_ld(&(bar)[XB_TMO])) break; if (_sp > XB_SPIN_CAP) { atomicAdd(&(bar)[XB_TMO], 1u); break; } } } } while (0)
__device__ __forceinline__ void xcd_barrier_complete(unsigned* bar, unsigned x, unsigned& nloc, unsigned& nx) {
    const unsigned G = gridDim.x * gridDim.y * gridDim.z;
    unsigned sum, cnt, mine, sp = 0u;
    for (;;) {
        sum = 0u; cnt = 0u; mine = 0u;
#pragma unroll
        for (unsigned j = 0; j < 16; ++j) { const unsigned c = xb_ld(&bar[XB_XCNT(j)]); sum += c; cnt += (c > 0u) ? 1u : 0u; mine = (j == x) ? c : mine; }
        if (sum == G) break;
        __builtin_amdgcn_s_sleep(1);
        if ((++sp & 255u) == 0u) { if (xb_ld(&bar[XB_TMO])) break; if (sp > XB_SPIN_CAP) { atomicAdd(&bar[XB_TMO], 1u); break; } }
    }
    nloc = mine > 0u ? mine : 1u; nx = cnt > 0u ? cnt : 1u;
}
__device__ __forceinline__ void xcd_barrier(unsigned* bar, volatile LAS unsigned* st) {
    asm volatile("s_waitcnt vmcnt(0)" ::: "memory");
    __syncthreads();
    if (threadIdx.x == 0) {
        const unsigned x = xb_xcc_id();
        __builtin_amdgcn_s_waitcnt(0);
        unsigned nloc = st[0], nx = st[1];
        if (nloc == 0u) { xcd_barrier_complete(bar, x, nloc, nx); st[0] = nloc; st[1] = nx; }
        const unsigned old = xb_add(&bar[XB_XSUB(x)], 1u);
        const unsigned gen = old / nloc;
        if (old + 1u == (gen + 1u) * nloc) {
            __builtin_amdgcn_fence(__ATOMIC_RELEASE, "agent");
            asm volatile("s_waitcnt vmcnt(0)" ::: "memory");
            const unsigned og = xb_add(&bar[XB_TOP], 1u);
            const unsigned tg = og / nx;
            if (og + 1u == (tg + 1u) * nx) xb_add(&bar[XB_TOPGEN], 1u);
            else XB_SPIN(xb_ld(&bar[XB_TOPGEN]) == tg, bar);
            __builtin_amdgcn_fence(__ATOMIC_ACQUIRE, "agent");
            xb_add(&bar[XB_XGEN(x)], 1u);
            asm volatile("s_waitcnt vmcnt(0)" ::: "memory");
        } else {
            XB_SPIN(xb_ld(&bar[XB_XGEN(x)]) == gen, bar);
            __builtin_amdgcn_fence(__ATOMIC_ACQUIRE, "agent");
            asm volatile("s_waitcnt vmcnt(0)" ::: "memory");
        }
    }
    __syncthreads();
}
constexpr int LDS_XB = 159696;
#define GRID_BAR() xcd_barrier((unsigned*)(fresh_args()->ws + WS_BAR), (volatile LAS unsigned*)(lds + LDS_XB))

constexpr int NPHASES = 1 + 5 * DEPTH;
#ifndef PROBE
#define PROBE 0
#endif
__global__ void __launch_bounds__(NTHR) mk_fwd(Args a_unused) {
    extern __shared__ __attribute__((aligned(16))) unsigned char lds_raw[];
    LAS unsigned char* lds = (LAS unsigned char*)lds_raw;
    { unsigned* bar0 = (unsigned*)(fresh_args()->ws + WS_BAR);
      if (threadIdx.x == 0) { ((volatile LAS unsigned*)(lds + LDS_XB))[0] = 0u; ((volatile LAS unsigned*)(lds + LDS_XB))[1] = 0u;
        (void)xb_add(&bar0[XB_XCNT(xb_xcc_id())], 1u); } }
    __syncthreads();
#define IN(k) (fresh_args()->ph_lo <= (k) && (k) < fresh_args()->ph_hi)
#define SEAM(k) do { if (fresh_args()->coop && IN(k) && IN((k) + 1)) { GRID_BAR(); } } while (0)
    if (fresh_args()->coop == 2) cg::this_grid().sync();
    if (IN(0)) { p0_phase(fresh_args(), lds); }
    if (PROBE == 1) { for (int i = 0; i < 16; ++i) GRID_BAR(); }
    if (PROBE == 2) { cg::this_grid().sync(); p0_phase(fresh_args(), lds); }
    SEAM(0);
#pragma nounroll
    for (int l = 0; l < DEPTH; ++l) {
        const int pb = 1 + 5 * l;
        if (IN(pb)) for (int rep_ = 0; rep_ < (PROBE == 3 ? 2 : 1); ++rep_) {
            KArgs a = fresh_args();
            pg8::DualOrder SD; SD.s0.init(NTOK, LDZ, gridDim.x, blockIdx.x, 8); SD.s1.init(NVT, NTOK, gridDim.x, blockIdx.x, 8); SD.G = gridDim.x; SD.c = blockIdx.x;
            SD.A0 = (const bf16_t*)(a->ws + WS_H); SD.B0 = (const bf16_t*)(a->ws + WS_W1T) + (size_t)l * LDZ * DM;
            SD.A1 = (const bf16_t*)(a->ws + WS_WVT) + (size_t)l * DM * DM; SD.B1 = (const bf16_t*)(a->ws + WS_H);
            pg8::Gemm g1{SD.A0, SD.B0, NTOK, LDZ, DM};
            pg8::EpiBf16 E1{(bf16_t*)(a->ws + WS_Z1), -1, (const float*)(a->ws + WS_SS2), (bf16_t*)(a->ws + WS_VT)};
            pg8::gemm_phase<pg8::EpiBf16, pg8::DualOrder, false, true>(lds, g1, SD, E1);
            if (rep_ == 0 && l + 1 < DEPTH && blockIdx.x >= 160 && gridDim.x == 256) convert_layer(fresh_args(), l + 1, lds, (blockIdx.x - 160) * NWAVES + __builtin_amdgcn_readfirstlane(opaque_tid() >> 6), 96 * NWAVES);
            else if (rep_ == 0 && l + 1 < DEPTH && gridDim.x != 256) convert_layer(fresh_args(), l + 1, lds, blockIdx.x * NWAVES + __builtin_amdgcn_readfirstlane(opaque_tid() >> 6), gridDim.x * NWAVES);
        }
        SEAM(pb);
        if (IN(pb + 1)) for (int rep_ = 0; rep_ < (PROBE == 4 ? 2 : 1); ++rep_) {
#ifdef NAIVE_GLA
            for (int it = blockIdx.x; it < 512; it += gridDim.x) attn_item(fresh_args(), l, it, lds);
            for (int it = blockIdx.x; it < 256; it += gridDim.x) { __syncthreads(); gla_naive_item(fresh_args(), l, it, lds); }
#else
            const int x0 = blockIdx.x & 7;
            unsigned* evt = (unsigned*)(fresh_args()->ws + WS_PCN) + (DEPTH * 32 + l * 2 + rep_) * 16;
            const bool chainwg = blockIdx.x < 64 && gridDim.x == 256;
            if (!chainwg) {
                const int nprep = gridDim.x == 256 ? 192 : (int)gridDim.x, pid = gridDim.x == 256 ? (int)blockIdx.x - 64 : (int)blockIdx.x;
                for (int it = pid; it < 512; it += nprep) gla_prep_item(fresh_args(), l, it, lds);
                asm volatile("s_waitcnt vmcnt(0)" ::: "memory"); __syncthreads();
                if (threadIdx.x == 0) { __builtin_amdgcn_fence(__ATOMIC_RELEASE, "agent"); asm volatile("s_waitcnt vmcnt(0)" ::: "memory"); __hip_atomic_fetch_add(evt, 1u, __ATOMIC_RELAXED, __HIP_MEMORY_SCOPE_AGENT); }
            }
            if (gridDim.x != 256) { if (fresh_args()->coop) GRID_BAR(); }
            if (blockIdx.x < 64) {
                if (chainwg) {
                    unsigned* qh0 = (unsigned*)(fresh_args()->ws + WS_CTR) + ((l * 2 + rep_) * 8 + x0) * 16;
                    __syncthreads();
                    if (threadIdx.x == 0) { int q_ = 64; if (__hip_atomic_load(qh0, __ATOMIC_RELAXED, __HIP_MEMORY_SCOPE_AGENT) < 64u) q_ = (int)atomicAdd(qh0, 1u); *(LAS int*)(lds + 159680) = q_; }
                    __syncthreads();
                    const int q = *(LAS int*)(lds + 159680);
                    if (q < 64) { const int pair = 2 * x0 + (q & 1), c = 31 - (q >> 1); attn_item(fresh_args(), l, ((pair >> 2) << 7) | (c << 2) | (pair & 3), lds); }
                    __syncthreads();
                    if (threadIdx.x == 0) { unsigned sp = 0;
                        while (__hip_atomic_load(evt, __ATOMIC_RELAXED, __HIP_MEMORY_SCOPE_AGENT) < 192u) { __builtin_amdgcn_s_sleep(2); if (++sp > (1u << 22)) break; }
                        __builtin_amdgcn_fence(__ATOMIC_ACQUIRE, "agent"); asm volatile("s_waitcnt vmcnt(0)" ::: "memory"); }
                    __syncthreads();
                }
                const int idx = blockIdx.x >> 3; gla_chain(fresh_args(), l, ((2 * x0 + (idx >> 2)) << 2) | (idx & 3), lds);
            }
            for (int dx = 0; dx < 8; ++dx) {
                const int x = (x0 + dx) & 7;
                unsigned* qh = (unsigned*)(fresh_args()->ws + WS_CTR) + ((l * 2 + rep_) * 8 + x) * 16;
                for (;;) {
                    __syncthreads();
                    if (threadIdx.x == 0) { int q_ = 64; if (__hip_atomic_load(qh, __ATOMIC_RELAXED, __HIP_MEMORY_SCOPE_AGENT) < 64u) q_ = (int)atomicAdd(qh, 1u); *(LAS int*)(lds + 159680) = q_; }
                    __syncthreads();
                    const int q = *(LAS int*)(lds + 159680);
                    if (q >= 64) break;
                    const int pair = 2 * x + (q & 1), c = 31 - (q >> 1);
                    attn_item(fresh_args(), l, ((pair >> 2) << 7) | (c << 2) | (pair & 3), lds);
                }
            }
#endif
        }
        SEAM(pb + 1);
#ifdef NAIVE_GLA
        if (IN(pb + 2)) { gla_norm_phase(fresh_args(), l); }
#endif
        SEAM(pb + 2);
        if (IN(pb + 3)) for (int rep_ = 0; rep_ < (PROBE == 5 ? 2 : 1); ++rep_) {
            KArgs a = fresh_args();
            pg8::StaticOrder S3; S3.init(NTOK, DM, gridDim.x, blockIdx.x);
            pg8::Gemm g3{(const bf16_t*)(a->ws + WS_MB), (const bf16_t*)(a->ws + WS_WOT) + (size_t)l * DM * DM, NTOK, DM, DM};
            pg8::EpiF32SS E3{(const float*)(a->ws + WS_SSP), l == 0 ? a->x : a->out, a->out, a->g_post + (size_t)l * DM, a->g_pre + (size_t)(l + 1 < DEPTH ? l + 1 : 0) * DM, (bf16_t*)(a->ws + WS_H),
                             (float*)(a->ws + WS_SSY), (float*)(a->ws + WS_SS2), (unsigned*)(a->ws + WS_PCN) + (size_t)l * 32 * 16, l + 1 < DEPTH ? 1 : 0};
            pg8::gemm_phase<pg8::EpiF32SS, pg8::StaticOrder>(lds, g3, S3, E3);
        }
        SEAM(pb + 3);
    }
#undef IN
#undef SEAM
}

extern "C" void kernel_launch(void* const* d_in, const int* in_sizes, int n_in, void* d_out, int out_size, void* d_ws, size_t ws_size, hipStream_t stream) {
    static int grid = 0;
    if (grid == 0) {
        if (n_in != 10 || out_size != NTOK * DM || ws_size < WS_END) { fprintf(stderr, "kernel_launch: unexpected shapes (n_in %d out %d ws %zu need %zu)\n", n_in, out_size, ws_size, (size_t)WS_END); grid = -1; return; }
        int dev = 0, cus = 0, per_cu = 0;
        (void)hipGetDevice(&dev); (void)hipDeviceGetAttribute(&cus, hipDeviceAttributeMultiprocessorCount, dev);
        (void)hipFuncSetAttribute((const void*)mk_fwd, hipFuncAttributeMaxDynamicSharedMemorySize, LDS_BYTES);
        (void)hipOccupancyMaxActiveBlocksPerMultiprocessor(&per_cu, (const void*)mk_fwd, NTHR, LDS_BYTES);
        if (per_cu < 1) { fprintf(stderr, "kernel_launch: occupancy query says %d blocks per CU\n", per_cu); per_cu = 1; }
        (void)hipGetLastError();
        grid = cus;
    }
    if (grid < 0) return;
    Args ka{};
    ka.x = (const float*)d_in[0]; ka.w_in = (const float*)d_in[1]; ka.w_out = (const float*)d_in[2]; ka.g_pre = (const float*)d_in[3]; ka.g_post = (const float*)d_in[4];
    ka.w_alpha = (const float*)d_in[5]; ka.b_alpha = (const float*)d_in[6]; ka.g_gla = (const float*)d_in[7]; ka.g_att = (const float*)d_in[8]; ka.rel_bias = (const float*)d_in[9];
    ka.out = (float*)d_out; ka.ws = (unsigned char*)d_ws; ka.pad = 0;
#if 0
    ka.coop = 0;
    for (int p = 0; p < NPHASES; ++p) { ka.ph_lo = p; ka.ph_hi = p + 1; hipLaunchKernelGGL(mk_fwd, dim3(grid), dim3(NTHR), LDS_BYTES, stream, ka); }
#else
    ka.coop = 1; ka.ph_lo = 0; ka.ph_hi = NPHASES;
    (void)hipMemsetAsync((char*)d_ws + WS_BAR, 0, XCD_BAR_WORDS * 4, stream);
    void* args[] = {&ka};
    hipError_t e = hipLaunchCooperativeKernel((const void*)mk_fwd, dim3(grid), dim3(NTHR), args, LDS_BYTES, stream);
    if (e != hipSuccess) fprintf(stderr, "cooperative launch failed: %s (grid %d)\n", hipGetErrorString(e), grid);
#endif
}
```

```cpp
#include <hip/hip_runtime.h>
#include <hip/hip_cooperative_groups.h>
#include <cstdio>
namespace cg = cooperative_groups;

#define LAS __attribute__((address_space(3)))
typedef unsigned short bf16_t;
typedef short bf16x8 __attribute__((ext_vector_type(8)));
typedef float f32x4 __attribute__((ext_vector_type(4)));
typedef unsigned u32x4 __attribute__((ext_vector_type(4)));
typedef unsigned u32x2 __attribute__((ext_vector_type(2)));
typedef float f32x16 __attribute__((ext_vector_type(16)));

constexpr int DM = 2048, NTOK = 8192, SEQ = 2048, DEPTH = 4, CHUNK = 64, NCH = 32;
constexpr int D_IN = 7184;
constexpr int LDZ = 5376;
constexpr int ZGQ = 0, ZGK = 512, ZGG = 1024, ZAQ = 2048, ZAK = 3072, ZAG = 4096, ZGA = 5120;
constexpr int NVT = 2048;
constexpr float EPS = 1e-6f;
__host__ __device__ __forceinline__ constexpr size_t zaddr(int tok, int col) { return (size_t)(col >> 7) * ((size_t)8192 * 128) + (size_t)tok * 128 + (col & 127); }
__host__ __device__ __forceinline__ constexpr size_t vaddr(int d, int tok) { return (size_t)(tok >> 6) * ((size_t)2048 * 64) + (size_t)d * 64 + (tok & 63); }
constexpr int NTHR = 512, NWAVES = 8;
constexpr int LDS_BYTES = 156 * 1024;

constexpr size_t SZ_W1T = (size_t)LDZ * DM * 2, SZ_WSQ = (size_t)DM * DM * 2;
constexpr size_t WS_W1T = 0;
constexpr size_t WS_WVT = WS_W1T + DEPTH * SZ_W1T;
constexpr size_t WS_WOT = WS_WVT + DEPTH * SZ_WSQ;
constexpr size_t WS_H   = WS_WOT + DEPTH * SZ_WSQ;
constexpr size_t WS_Z1  = WS_H + (size_t)NTOK * DM * 2;
constexpr size_t WS_VT  = WS_Z1 + (size_t)NTOK * LDZ * 2;
constexpr size_t WS_MB  = WS_VT + (size_t)NVT * NTOK * 2;
constexpr size_t WS_Y   = WS_MB + (size_t)NTOK * DM * 2;
constexpr size_t WS_ORAW = WS_Y + (size_t)NTOK * DM * 4;
constexpr size_t WS_RSS = WS_ORAW + (size_t)NTOK * 1024 * 4;
constexpr size_t WS_SSY = WS_RSS;
constexpr size_t WS_SS2 = WS_RSS + (size_t)NTOK * 8 * 4;
constexpr size_t WS_PCN = WS_RSS + (size_t)NTOK * 16 * 4;
constexpr size_t WS_SSP = WS_RSS + (size_t)NTOK * 32 * 4;
constexpr size_t WS_CTR = WS_SSP + (size_t)NTOK * 16 * 4;
constexpr size_t WS_KD = WS_CTR + 4096;
constexpr size_t WS_AD = WS_KD + (size_t)512 * 8192 * 2;
constexpr size_t WS_BAR = WS_AD + (size_t)512 * 128 * 4;
constexpr size_t WS_END = WS_BAR + 3456 * 4;

typedef float f32x2 __attribute__((ext_vector_type(2)));
typedef __bf16 bf16x2_t __attribute__((ext_vector_type(2)));
__device__ __forceinline__ unsigned pk2(float lo, float hi) { const f32x2 v = {lo, hi}; const bf16x2_t r = __builtin_convertvector(v, bf16x2_t); return __builtin_bit_cast(unsigned, r); }
__device__ __forceinline__ unsigned f2bf(float f) { return pk2(f, 0.f) & 0xffffu; }
__device__ __forceinline__ float bf2f(bf16_t b) { return __uint_as_float(((unsigned)b) << 16); }
__device__ __forceinline__ float wave_sum(float v) {
#pragma unroll
    for (int o = 1; o < 64; o <<= 1) v += __shfl_xor(v, o);
    return v;
}
__device__ __forceinline__ float silu_f(float x) { return x / (1.0f + __expf(-x)); }
__device__ __forceinline__ float logsigmoid_f(float x) { return fminf(x, 0.f) - log1pf(__expf(-fabsf(x))); }
__device__ __forceinline__ float logsigmoid_fast(float x) { return fminf(x, 0.f) - __logf(1.0f + __expf(-fabsf(x))); }
__device__ __forceinline__ int opaque_tid() { int t = threadIdx.x; asm volatile("" : "+v"(t)); return t; }
#define LDS_WAIT() asm volatile("s_waitcnt lgkmcnt(0)" ::: "memory")

namespace pg8 {
#define PG8_LAS __attribute__((address_space(3)))
constexpr int BM = 256, BK = 64, HALF = 128, HTB = HALF * BK * 2, STAGE_BYTES = 8 * HTB, NXCD = 8, WGM = 2;
__host__ __device__ __forceinline__ int lds_byte(int r, int c) { const int st = (r >> 4) * 2 + (c >> 5), rr = r & 15, cc = c & 31, ob = rr * 64 + cc * 2; return st * 1024 + (ob ^ (((ob >> 9) & 1) << 5)); }
__host__ __device__ __forceinline__ void stage_rc(int b, int& R, int& C) { const int st = b / 1024, sb = b % 1024, swz = sb ^ (((sb >> 9) & 1) << 5); R = (st >> 1) * 16 + swz / 64; C = (st & 1) * 32 + (swz % 64) / 2; }
__host__ __device__ __forceinline__ int perm32(int rho) { const int n = rho >> 4, i = rho & 15; return 8 * (i >> 2) + 4 * n + (i & 3); }
struct Unit { int pm, pn, which; };
struct Gemm { const bf16_t* A; const bf16_t* Bt; int M, N, K; };
struct StaticOrder {
    int nM, nN, nwg, G, c, wgm;
    __host__ __device__ void init(int M, int N, int G_, int c_, int wgm_ = WGM) { nM = M / BM; nN = N / BM; nwg = nM * nN; G = G_; c = c_; wgm = wgm_; }
    __host__ __device__ bool next(int i, Unit& u) const { const long L = (long)i * G + c; if (L >= nwg) return false; u.which = 0; decode((int)L, u); return true; }
    __device__ __forceinline__ const bf16_t* opA(const Gemm& g, const Unit&) const { return g.A; }
    __device__ __forceinline__ const bf16_t* opB(const Gemm& g, const Unit&) const { return g.Bt; }
    __host__ __device__ void decode(int L, Unit& u) const {
        int wgid = L; { const int q = nwg / NXCD, r = nwg % NXCD, xcd = wgid % NXCD, off = wgid / NXCD; wgid = (xcd < r ? xcd * (q + 1) : r * (q + 1) + (xcd - r) * q) + off; }
        const int nig = wgm * nN, gid = wgid / nig, fm = gid * wgm, gsz = (nM - fm) < wgm ? (nM - fm) : wgm;
        u.pm = fm + ((wgid % nig) % gsz); u.pn = (wgid % nig) / gsz;
    }
    __device__ __forceinline__ void a_ready(const Unit&) const {}
    __device__ __forceinline__ void done(const Unit&) const {}
};
struct DualOrder {
    StaticOrder s0, s1; const bf16_t *A0, *B0, *A1, *B1; int G, c;
    __host__ __device__ bool next(int i, Unit& u) const { const long L = (long)i * G + c; if (L >= s0.nwg + s1.nwg) return false;
        if (L < s0.nwg) { u.which = 0; s0.decode((int)L, u); } else { u.which = 1; s1.decode((int)L - s0.nwg, u); } return true; }
    __device__ __forceinline__ const bf16_t* opA(const Gemm&, const Unit& u) const { return u.which ? A1 : A0; }
    __device__ __forceinline__ const bf16_t* opB(const Gemm&, const Unit& u) const { return u.which ? B1 : B0; }
    __device__ __forceinline__ void a_ready(const Unit&) const {}
    __device__ __forceinline__ void done(const Unit&) const {}
};
__device__ __forceinline__ unsigned cvt_pk_bf16(float lo, float hi) { return pk2(lo, hi); }

struct EpiBf16 {
    static constexpr bool PERM = true, KSCALE = false, AFTER_DRAIN = false;
    bf16_t* O; int mode_;
    const float* ss2; bf16_t* O1;
    __device__ __forceinline__ float tok_rstd(int tok) const { const f32x4 p0 = *(const f32x4*)(ss2 + (size_t)tok * 8), p1 = *(const f32x4*)(ss2 + (size_t)tok * 8 + 4);
        return rsqrtf((((p0[0] + p0[1]) + (p0[2] + p0[3])) + ((p1[0] + p1[1]) + (p1[2] + p1[3]))) * (1.0f / DM) + EPS); }
    __device__ __forceinline__ void operator()(const f32x4 (&acc)[2][2][4][2], const Unit& u, int wr, int wc, int fr, int fq) const {
        const int row0 = u.pm * BM + wr * 64 + fr; const int col0 = u.pn * BM + wc * 32 + 8 * fq;
        const int mode = mode_ < 0 ? u.which : mode_; bf16_t* const Ob = (mode_ < 0 && u.which) ? O1 : O;
        const size_t rstep = mode == 0 ? (size_t)16 * 128 : (size_t)16 * 64, hstepr = mode == 0 ? (size_t)HALF * 128 : (size_t)HALF * 64;
        const size_t cstep = mode == 0 ? (size_t)NTOK * 128 : (size_t)2 * NVT * 64;
        bf16_t* base = Ob + (mode == 0 ? zaddr(row0, col0) : vaddr(row0, col0));
#pragma unroll
        for (int ai = 0; ai < 2; ++ai)
#pragma unroll
            for (int m = 0; m < 4; ++m) { bf16_t* rowp = base + ai * hstepr + m * rstep;
#pragma unroll
                for (int bj = 0; bj < 2; ++bj) { const f32x4 v0 = acc[ai][bj][m][0], v1 = acc[ai][bj][m][1];
                    u32x4 w; w.x = cvt_pk_bf16(v0[0], v0[1]); w.y = cvt_pk_bf16(v0[2], v0[3]); w.z = cvt_pk_bf16(v1[0], v1[1]); w.w = cvt_pk_bf16(v1[2], v1[3]);
                    *(u32x4*)(rowp + bj * cstep) = w; } }
    }
};
struct EpiF32SS {
    static constexpr bool PERM = false, KSCALE = true;
    __device__ __forceinline__ void kscale(f32x4 (&acc)[2][2][4][2], int t, PG8_LAS unsigned char* lds, int wr, int fr) const {
        const PG8_LAS float* tab = (const PG8_LAS float*)(lds + 131072) + ((t >> 2) - 1) * 256 + wr * 64 + fr;
#pragma unroll
        for (int ai = 0; ai < 2; ++ai)
#pragma unroll
            for (int m = 0; m < 4; ++m) { const float r = tab[ai * HALF + m * 16];
#pragma unroll
                for (int bj = 0; bj < 2; ++bj)
#pragma unroll
                    for (int n = 0; n < 2; ++n) acc[ai][bj][m][n] *= r; }
        asm volatile("s_waitcnt lgkmcnt(0)" ::: "memory");
    }
    static constexpr bool AFTER_DRAIN = true;
    const float* xin; float* out; const float* gpost; const float* gpre; bf16_t* H; float* ssy; float* ss2; unsigned* cnt; int wantH;
    __device__ __forceinline__ void operator()(const f32x4 (&)[2][2][4][2], const Unit&, int, int, int, int) const {}
    __device__ __forceinline__ void fused(f32x4 (&acc)[2][2][4][2], const Unit& u, int wr, int wc, int fr, int fq, PG8_LAS unsigned char* lds, int tid) const {
        PG8_LAS float* P = (PG8_LAS float*)lds;
        PG8_LAS float* Srow = (PG8_LAS float*)(lds + 4096);
        const int col0 = u.pn * BM + wc * 32 + 4 * fq;
        f32x4 xa[4][4], gpo[4];
#pragma unroll
        for (int q = 0; q < 4; ++q) gpo[q] = *(const f32x4*)(gpost + col0 + (q >> 1) * HALF + (q & 1) * 16);
#pragma unroll
        for (int m = 0; m < 4; ++m)
#pragma unroll
            for (int q = 0; q < 4; ++q) xa[m][q] = *(const f32x4*)(xin + (size_t)(u.pm * BM + wr * 64 + m * 16 + fr) * DM + col0 + (q >> 1) * HALF + (q & 1) * 16);
#pragma unroll
        for (int ai = 0; ai < 2; ++ai)
#pragma unroll
            for (int m = 0; m < 4; ++m) { float s = 0.f;
#pragma unroll
                for (int bj = 0; bj < 2; ++bj)
#pragma unroll
                    for (int n = 0; n < 2; ++n) { const f32x4 x = acc[ai][bj][m][n]; s += (x[0] * x[0] + x[1] * x[1]) + (x[2] * x[2] + x[3] * x[3]); }
                s += __shfl_xor(s, 16); s += __shfl_xor(s, 32);
                if (fq == 0) P[(ai * HALF + wr * 64 + m * 16 + fr) * 4 + wc] = s; }
        asm volatile("s_waitcnt lgkmcnt(0)" ::: "memory"); __builtin_amdgcn_s_barrier(); asm volatile("" ::: "memory");
        if (tid < 256) { const f32x4 p = ((const PG8_LAS f32x4*)P)[tid];
            __hip_atomic_store(ssy + (size_t)(u.pm * BM + tid) * 8 + u.pn, (p[0] + p[1]) + (p[2] + p[3]), __ATOMIC_RELAXED, __HIP_MEMORY_SCOPE_AGENT); }
        asm volatile("s_waitcnt vmcnt(0)" ::: "memory"); __builtin_amdgcn_s_barrier(); asm volatile("" ::: "memory");
        if (tid == 0) {
            __hip_atomic_fetch_add(cnt + 16 * u.pm, 1u, __ATOMIC_RELAXED, __HIP_MEMORY_SCOPE_AGENT);
            unsigned sp = 0;
            while (__hip_atomic_load(cnt + 16 * u.pm, __ATOMIC_RELAXED, __HIP_MEMORY_SCOPE_AGENT) < 8u) { __builtin_amdgcn_s_sleep(2); if (++sp > (1u << 22)) break; }
            __builtin_amdgcn_fence(__ATOMIC_ACQUIRE, "agent");
            asm volatile("s_waitcnt vmcnt(0)" ::: "memory");
        }
        __builtin_amdgcn_s_barrier(); asm volatile("" ::: "memory");
        if (tid < 256) { const float* sl = ssy + (size_t)(u.pm * BM + tid) * 8; float t = 0.f;
#pragma unroll
            for (int q = 0; q < 8; ++q) t += __hip_atomic_load(sl + q, __ATOMIC_RELAXED, __HIP_MEMORY_SCOPE_AGENT);
            Srow[tid] = rsqrtf(t * (1.0f / DM) + EPS); }
        asm volatile("s_waitcnt lgkmcnt(0)" ::: "memory"); __builtin_amdgcn_s_barrier(); asm volatile("" ::: "memory");
#pragma unroll
        for (int ai = 0; ai < 2; ++ai)
#pragma unroll
            for (int m = 0; m < 4; ++m) { const int r = ai * HALF + wr * 64 + m * 16 + fr; const float rstd = Srow[r]; const size_t off = (size_t)(u.pm * BM + r) * DM + col0; float s2 = 0.f;
#pragma unroll
                for (int q = 0; q < 4; ++q) { const int bj = q >> 1, n = q & 1, co = bj * HALF + n * 16;
                    const f32x4 xn = xa[m][q] + acc[ai][bj][m][n] * rstd * gpo[q];
                    *(f32x4*)(out + off + co) = xn; s2 += (xn[0] * xn[0] + xn[1] * xn[1]) + (xn[2] * xn[2] + xn[3] * xn[3]);
                    acc[ai][bj][m][n] = xn; }
                if (ai == 0) {
#pragma unroll
                    for (int q = 0; q < 4; ++q) xa[m][q] = *(const f32x4*)(xin + off + (size_t)HALF * DM + (q >> 1) * HALF + (q & 1) * 16); }
                s2 += __shfl_xor(s2, 16); s2 += __shfl_xor(s2, 32);
                if (fq == 0) P[r * 4 + wc] = s2; }
        asm volatile("s_waitcnt lgkmcnt(0)" ::: "memory"); __builtin_amdgcn_s_barrier(); asm volatile("" ::: "memory");
        if (!wantH) return;
        if (tid < 256) { const f32x4 p = ((const PG8_LAS f32x4*)P)[tid];
            __hip_atomic_store(ss2 + (size_t)(u.pm * BM + tid) * 8 + u.pn, (p[0] + p[1]) + (p[2] + p[3]), __ATOMIC_RELAXED, __HIP_MEMORY_SCOPE_AGENT); }
        asm volatile("s_waitcnt vmcnt(0)" ::: "memory"); __builtin_amdgcn_s_barrier(); asm volatile("" ::: "memory");
        if (tid == 0) {
            __hip_atomic_fetch_add(cnt + 16 * u.pm + 1, 1u, __ATOMIC_RELAXED, __HIP_MEMORY_SCOPE_AGENT);
            unsigned sp = 0;
            while (__hip_atomic_load(cnt + 16 * u.pm + 1, __ATOMIC_RELAXED, __HIP_MEMORY_SCOPE_AGENT) < 8u) { __builtin_amdgcn_s_sleep(2); if (++sp > (1u << 22)) break; }
            __builtin_amdgcn_fence(__ATOMIC_ACQUIRE, "agent");
            asm volatile("s_waitcnt vmcnt(0)" ::: "memory");
        }
        __builtin_amdgcn_s_barrier(); asm volatile("" ::: "memory");
        if (tid < 256) { const float* sl = ss2 + (size_t)(u.pm * BM + tid) * 8; float t = 0.f;
#pragma unroll
            for (int q = 0; q < 8; ++q) t += __hip_atomic_load(sl + q, __ATOMIC_RELAXED, __HIP_MEMORY_SCOPE_AGENT);
            Srow[tid] = rsqrtf(t * (1.0f / DM) + EPS); }
        asm volatile("s_waitcnt lgkmcnt(0)" ::: "memory"); __builtin_amdgcn_s_barrier(); asm volatile("" ::: "memory");
#pragma unroll
        for (int ai = 0; ai < 2; ++ai)
#pragma unroll
            for (int m = 0; m < 4; ++m) { const int r = ai * HALF + wr * 64 + m * 16 + fr; const float r2 = Srow[r]; const size_t off = (size_t)(u.pm * BM + r) * DM + col0;
#pragma unroll
                for (int bj = 0; bj < 2; ++bj)
#pragma unroll
                    for (int n = 0; n < 2; ++n) { const int co = bj * HALF + n * 16; const f32x4 xn = acc[ai][bj][m][n] * r2, gp4 = *(const f32x4*)(gpre + col0 + co);
                        u32x2 w; w.x = pk2(xn[0] * gp4[0], xn[1] * gp4[1]); w.y = pk2(xn[2] * gp4[2], xn[3] * gp4[3]); *(u32x2*)(H + off + co) = w; } }
    }
};

template <class Epi, class Sched, bool ALIGN_EPI = true, bool SP2 = true>
__device__ __forceinline__ void gemm_phase(PG8_LAS unsigned char* lds, const Gemm g, const Sched& S, const Epi& E) {
    int tid_l = threadIdx.x; asm volatile("" : "+v"(tid_l));
    const int tid = tid_l, wid = __builtin_amdgcn_readfirstlane(tid >> 6), lane = tid & 63, wr = wid >> 2, wc = wid & 3, fr = lane & 15, fq = lane >> 4;
    const int K = g.K, nt = K / BK;
    unsigned voffA[2], voffB[2];
#pragma unroll
    for (int i = 0; i < 2; ++i) { int R, C; stage_rc(tid * 16 + i * 8192, R, C); const int Rb = Epi::PERM ? ((R & ~31) + perm32(R & 31)) : R;
        voffA[i] = (unsigned)(R * K + C) * 2u; voffB[i] = (unsigned)(Rb * K + C) * 2u; }
    const size_t kstep = (size_t)(BK * 2);
    const size_t hstep = (size_t)HALF * K * 2;
    const size_t tstep = 2 * hstep;
    const unsigned ldsw = (unsigned)wid * 1024u;
    const int aoff = lds_byte(wr * 64 + fr, fq * 8), boff = lds_byte(wc * 32 + fr, fq * 8);
#define PG8_SA(b, h) (((b) * 2 + (h)) * HTB)
#define PG8_SB(b, h) ((4 + (b) * 2 + (h)) * HTB)
#define PG8_STAGE(bufoff, gbase, voff) do { _Pragma("unroll") for (int _i = 0; _i < 2; ++_i) \
        __builtin_amdgcn_global_load_lds((const unsigned*)((const char*)(gbase) + (voff)[_i]), (PG8_LAS unsigned*)(lds + (bufoff) + ldsw + _i * 8192), 16, 0, 0); } while (0)
#define PG8_LDA(dst, b, h) do { _Pragma("unroll") for (int m = 0; m < 4; ++m) _Pragma("unroll") for (int k = 0; k < 2; ++k) dst[m][k] = *(const PG8_LAS bf16x8*)(lds + PG8_SA(b, h) + aoff + m * 2048 + k * 1024); } while (0)
#define PG8_LDB(dst, b, h) do { _Pragma("unroll") for (int n = 0; n < 2; ++n) _Pragma("unroll") for (int k = 0; k < 2; ++k) dst[n][k] = *(const PG8_LAS bf16x8*)(lds + PG8_SB(b, h) + boff + n * 2048 + k * 1024); } while (0)
#define PG8_MMA(ai, bj, At, Bt) do { __builtin_amdgcn_s_setprio(1); _Pragma("unroll") for (int m = 0; m < 4; ++m) _Pragma("unroll") for (int n = 0; n < 2; ++n) _Pragma("unroll") for (int k = 0; k < 2; ++k) \
        acc[ai][bj][m][n] = __builtin_amdgcn_mfma_f32_16x16x32_bf16(Bt[n][k], At[m][k], acc[ai][bj][m][n], 0, 0, 0); __builtin_amdgcn_s_setprio(0); } while (0)
#define PG8_WAIT_V(n) asm volatile("s_waitcnt vmcnt(" #n ")" ::: "memory")
#define PG8_WAIT_L(n) asm volatile("s_waitcnt lgkmcnt(" #n ")" ::: "memory")
#define PG8_BAR __builtin_amdgcn_s_barrier()
#define PG8_SCHED __builtin_amdgcn_sched_barrier(0)
    Unit cur, nxt; int ui = 0;
    if (!S.next(0, cur)) return;
    f32x4 acc[2][2][4][2];
#pragma unroll
    for (int a = 0; a < 2; ++a)
#pragma unroll
        for (int b = 0; b < 2; ++b)
#pragma unroll
            for (int m = 0; m < 4; ++m)
#pragma unroll
                for (int n = 0; n < 2; ++n) acc[a][b][m][n] = (f32x4){0.f, 0.f, 0.f, 0.f};
    bf16x8 At[4][2], B0[2][2], B1[2][2];
    const char* cA = (const char*)S.opA(g, cur) + (size_t)cur.pm * tstep; const char* cB = (const char*)S.opB(g, cur) + (size_t)cur.pn * tstep;
    S.a_ready(cur);
    if constexpr (SP2) {
        PG8_STAGE(PG8_SB(0, 0), cB, voffB); PG8_STAGE(PG8_SB(0, 1), cB + hstep, voffB); PG8_STAGE(PG8_SA(0, 0), cA, voffA); PG8_STAGE(PG8_SA(0, 1), cA + hstep, voffA);
        if (wr == 1) PG8_BAR;
        PG8_WAIT_V(2); PG8_BAR;
        PG8_STAGE(PG8_SB(1, 0), cB + kstep, voffB); PG8_STAGE(PG8_SA(1, 0), cA + kstep, voffA); PG8_STAGE(PG8_SB(1, 1), cB + hstep + kstep, voffB);
        PG8_WAIT_V(6); PG8_BAR;
    } else {
        PG8_STAGE(PG8_SB(0, 0), cB, voffB); PG8_STAGE(PG8_SA(0, 0), cA, voffA); PG8_STAGE(PG8_SB(0, 1), cB + hstep, voffB); PG8_STAGE(PG8_SA(0, 1), cA + hstep, voffA);
        if (wr == 1) PG8_BAR;
        PG8_WAIT_V(4); PG8_BAR;
        PG8_STAGE(PG8_SB(1, 0), cB + kstep, voffB); PG8_STAGE(PG8_SA(1, 0), cA + kstep, voffA); PG8_STAGE(PG8_SB(1, 1), cB + hstep + kstep, voffB);
        PG8_WAIT_V(6); PG8_BAR;
    }
    for (;;) {
        const bool has_next = S.next(ui + 1, nxt);
        const char* nA = has_next ? (const char*)S.opA(g, nxt) + (size_t)nxt.pm * tstep : cA; const char* nB = has_next ? (const char*)S.opB(g, nxt) + (size_t)nxt.pn * tstep : cB;
        for (int t = 0; t < nt; t += 2) {
            const bool last = (t == nt - 2);
            const char* a1 = cA + (size_t)(t + 1) * kstep;
            const char* a2 = last ? nA : cA + (size_t)(t + 2) * kstep; const char* b2 = last ? nB : cB + (size_t)(t + 2) * kstep;
            const char* a3 = a2 + kstep; const char* b3 = b2 + kstep;
            if (last && has_next) S.a_ready(nxt);
            if constexpr (Epi::KSCALE) { if (t >= 4 && t <= 16 && (t & 3) == 0) { E.kscale(acc, t, lds, wr, fr); PG8_SCHED; } }
            if constexpr (SP2) {
            PG8_LDB(B0, 0, 0); PG8_LDB(B1, 0, 1); PG8_SCHED; PG8_LDA(At, 0, 0); PG8_STAGE(PG8_SA(1, 1), a1 + hstep, voffA);
            PG8_WAIT_V(8); PG8_WAIT_L(0); PG8_BAR; PG8_MMA(0, 0, At, B0); PG8_MMA(0, 1, At, B1); PG8_BAR; PG8_SCHED;
            PG8_LDA(At, 0, 1); PG8_STAGE(PG8_SB(0, 0), b2, voffB); PG8_STAGE(PG8_SB(0, 1), b2 + hstep, voffB); PG8_STAGE(PG8_SA(0, 0), a2, voffA);
            PG8_WAIT_V(8); PG8_WAIT_L(0); PG8_BAR; PG8_MMA(1, 0, At, B0); PG8_MMA(1, 1, At, B1); PG8_BAR; PG8_SCHED;
            PG8_LDB(B0, 1, 0); PG8_LDB(B1, 1, 1); PG8_SCHED; PG8_LDA(At, 1, 0); PG8_STAGE(PG8_SA(0, 1), a2 + hstep, voffA);
            PG8_WAIT_V(8); PG8_WAIT_L(0); PG8_BAR; PG8_MMA(0, 0, At, B0); PG8_MMA(0, 1, At, B1); PG8_BAR; PG8_SCHED;
            PG8_LDA(At, 1, 1); PG8_STAGE(PG8_SB(1, 0), b3, voffB); PG8_STAGE(PG8_SB(1, 1), b3 + hstep, voffB); PG8_STAGE(PG8_SA(1, 0), a3, voffA);
            PG8_WAIT_V(8); PG8_WAIT_L(0); PG8_BAR; PG8_MMA(1, 0, At, B0); PG8_MMA(1, 1, At, B1); PG8_BAR; PG8_SCHED;
            } else {
            PG8_LDB(B0, 0, 0); PG8_SCHED; PG8_LDA(At, 0, 0); PG8_STAGE(PG8_SA(1, 1), a1 + hstep, voffA);
            PG8_WAIT_L(8); PG8_BAR; PG8_WAIT_L(0); PG8_MMA(0, 0, At, B0); PG8_BAR; PG8_SCHED;
            PG8_LDB(B1, 0, 1); PG8_STAGE(PG8_SB(0, 0), b2, voffB);
            PG8_BAR; PG8_WAIT_L(0); PG8_MMA(0, 1, At, B1); PG8_BAR;
            PG8_LDA(At, 0, 1); PG8_STAGE(PG8_SA(0, 0), a2, voffA);
            PG8_BAR; PG8_WAIT_L(0); PG8_MMA(1, 0, At, B0); PG8_BAR; PG8_SCHED;
            PG8_STAGE(PG8_SB(0, 1), b2 + hstep, voffB);
            PG8_WAIT_V(6); PG8_BAR; PG8_MMA(1, 1, At, B1); PG8_BAR;
            PG8_LDB(B0, 1, 0); PG8_SCHED; PG8_LDA(At, 1, 0); PG8_STAGE(PG8_SA(0, 1), a2 + hstep, voffA);
            PG8_WAIT_L(8); PG8_BAR; PG8_WAIT_L(0); PG8_MMA(0, 0, At, B0); PG8_BAR; PG8_SCHED;
            PG8_LDB(B1, 1, 1); PG8_STAGE(PG8_SB(1, 0), b3, voffB);
            PG8_BAR; PG8_WAIT_L(0); PG8_MMA(0, 1, At, B1); PG8_BAR;
            PG8_LDA(At, 1, 1); PG8_STAGE(PG8_SA(1, 0), a3, voffA);
            PG8_BAR; PG8_WAIT_L(0); PG8_MMA(1, 0, At, B0); PG8_BAR; PG8_SCHED;
            PG8_STAGE(PG8_SB(1, 1), b3 + hstep, voffB);
            PG8_WAIT_V(6); PG8_BAR; PG8_MMA(1, 1, At, B1); PG8_BAR;
            }
        }
        if constexpr (ALIGN_EPI) { if (wr == 0) PG8_BAR; }
        if constexpr (!Epi::AFTER_DRAIN) { E(acc, cur, wr, wc, fr, fq); S.done(cur); }
        if (!has_next) break;
#pragma unroll
        for (int a = 0; a < 2; ++a)
#pragma unroll
            for (int b = 0; b < 2; ++b)
#pragma unroll
                for (int m = 0; m < 4; ++m)
#pragma unroll
                    for (int n = 0; n < 2; ++n) acc[a][b][m][n] = (f32x4){0.f, 0.f, 0.f, 0.f};
        cur = nxt; cA = nA; cB = nB; ++ui;
        if constexpr (ALIGN_EPI) { if (wr == 1) PG8_BAR; }
    }
    PG8_WAIT_V(0);
    if constexpr (!ALIGN_EPI) { if (wr == 0) PG8_BAR; }
    PG8_BAR;
    if constexpr (Epi::AFTER_DRAIN) { E.fused(acc, cur, wr, wc, fr, fq, lds, tid); }
#undef PG8_SA
#undef PG8_SB
#undef PG8_STAGE
#undef PG8_LDA
#undef PG8_LDB
#undef PG8_MMA
#undef PG8_WAIT_V
#undef PG8_WAIT_L
#undef PG8_BAR
#undef PG8_SCHED
}
}

struct Args {
    const float* x; const float* w_in; const float* w_out; const float* g_pre; const float* g_post;
    const float* w_alpha; const float* b_alpha; const float* g_gla; const float* g_att; const float* rel_bias;
    float* out; unsigned char* ws;
    int ph_lo, ph_hi, coop, pad;
};

typedef const __attribute__((address_space(4))) Args* KArgs;
__device__ __forceinline__ KArgs fresh_args() { KArgs p = (KArgs)__builtin_amdgcn_kernarg_segment_ptr(); asm volatile("" : "+s"(p)); return p; }
__device__ __forceinline__ bf16_t* win_dest(int j, bf16_t* W1T, bf16_t* WVT) {
    if (j < 1024) return W1T + (size_t)j * DM;
    if (j < 2048) return WVT + (size_t)(j - 1024) * DM;
    if (j < 3072) return W1T + (size_t)(j - 1024) * DM;
    if (j < 3088) return W1T + (size_t)(ZGA + (j - 3072)) * DM;
    if (j < 4112) return W1T + (size_t)(ZAQ + (j - 3088)) * DM;
    if (j < 5136) return W1T + (size_t)(ZAK + (j - 4112)) * DM;
    if (j < 6160) return WVT + (size_t)(1024 + (j - 5136)) * DM;
    return W1T + (size_t)(ZAG + (j - 6160)) * DM;
}
template <bool IS_IN>
__device__ __forceinline__ void p0_item(const float* W, int N, LAS float* scr, int item, int lane, bf16_t* D0, bf16_t* D1) {
    const int nblk = (N + 63) / 64, kb = item / nblk, nb = item % nblk, k0 = 64 * kb, n0 = 64 * nb;
    const int n4 = (lane & 15) * 4; const bool okr = n0 + n4 < N;
    const float* wp = W + (size_t)(k0 + (lane >> 4)) * N + n0 + n4;
    f32x4 v[16];
#pragma unroll
    for (int i = 0; i < 16; ++i) v[i] = okr ? __builtin_nontemporal_load((const f32x4*)(wp + (size_t)(4 * i) * N)) : (f32x4){0.f, 0.f, 0.f, 0.f};
#pragma unroll
    for (int i = 0; i < 16; ++i) { LAS float* s = scr + (4 * i + (lane >> 4)) * 65 + n4; s[0] = v[i][0]; s[1] = v[i][1]; s[2] = v[i][2]; s[3] = v[i][3]; }
    LDS_WAIT(); asm volatile("" ::: "memory");
    const int c = lane & 7;
#pragma unroll
    for (int j = 0; j < 8; ++j) { const int n = (lane >> 3) + 8 * j; const LAS float* s = scr + (8 * c) * 65 + n;
        u32x4 o; o.x = pk2(s[0 * 65], s[1 * 65]); o.y = pk2(s[2 * 65], s[3 * 65]); o.z = pk2(s[4 * 65], s[5 * 65]); o.w = pk2(s[6 * 65], s[7 * 65]);
        const int ns = n0 + n;
        if (ns < N) { bf16_t* d = IS_IN ? win_dest(ns, D0, D1) : D0 + (size_t)ns * DM; *(u32x4*)(d + k0 + 8 * c) = o; } }
    LDS_WAIT(); asm volatile("" ::: "memory");
}

__device__ __forceinline__ void rowpass0(KArgs a) {
    const int tid = opaque_tid(), lane = tid & 63, gw = blockIdx.x * NWAVES + (tid >> 6), NGW = gridDim.x * NWAVES;
    bf16_t* H = (bf16_t*)(a->ws + WS_H);
    f32x4 nx[8];
    { const f32x4* xr = (const f32x4*)(a->x + (size_t)(gw < NTOK ? gw : 0) * DM) + lane;
#pragma unroll
      for (int j = 0; j < 8; ++j) nx[j] = xr[64 * j]; }
    for (int row = gw; row < NTOK; row += NGW) {
        f32x4 v[8];
#pragma unroll
        for (int j = 0; j < 8; ++j) v[j] = nx[j];
        { const int rn = row + NGW < NTOK ? row + NGW : row; const f32x4* xr = (const f32x4*)(a->x + (size_t)rn * DM) + lane;
#pragma unroll
          for (int j = 0; j < 8; ++j) nx[j] = xr[64 * j]; }
        float s = 0.f;
#pragma unroll
        for (int j = 0; j < 8; ++j) s += (v[j][0] * v[j][0] + v[j][1] * v[j][1]) + (v[j][2] * v[j][2] + v[j][3] * v[j][3]);
        s = wave_sum(s);
        const float r2 = rsqrtf(s * (1.0f / DM) + EPS);
        const f32x4* gq = (const f32x4*)a->g_pre + lane; u32x2* ho = (u32x2*)(H + (size_t)row * DM) + lane;
#pragma unroll
        for (int j = 0; j < 8; ++j) { const f32x4 g = gq[64 * j]; u32x2 w; w.x = pk2(v[j][0] * r2 * g[0], v[j][1] * r2 * g[1]); w.y = pk2(v[j][2] * r2 * g[2], v[j][3] * r2 * g[3]); ho[64 * j] = w; }
    }
}

__device__ __forceinline__ void convert_layer(KArgs a, int l, LAS unsigned char* lds, int wk, int nwk) {
    const int tid0 = opaque_tid(), lane = tid0 & 63, wave = __builtin_amdgcn_readfirstlane(tid0 >> 6);
    LAS float* scr = (LAS float*)(lds + wave * 16640);
    constexpr int I_IN = 32 * 113, I_OUT = 32 * 32;
    bf16_t* W1T = (bf16_t*)(a->ws + WS_W1T) + (size_t)l * LDZ * DM; bf16_t* WVT = (bf16_t*)(a->ws + WS_WVT) + (size_t)l * DM * DM; bf16_t* WOT = (bf16_t*)(a->ws + WS_WOT) + (size_t)l * DM * DM;
    for (int r = wk; r < I_IN + I_OUT; r += nwk) {
        if (r < I_IN) p0_item<true>(a->w_in + (size_t)l * DM * D_IN, D_IN, scr, r, lane, W1T, WVT);
        else p0_item<false>(a->w_out + (size_t)l * DM * DM, DM, scr, r - I_IN, lane, WOT, nullptr);
    }
}
__device__ __forceinline__ void p0_phase(KArgs a, LAS unsigned char* lds) {
    const int tid0 = opaque_tid(), lane = tid0 & 63, wave = __builtin_amdgcn_readfirstlane(tid0 >> 6);
    LAS float* scr = (LAS float*)(lds + wave * 16640);
    const int gw = blockIdx.x * NWAVES + wave, NGW = gridDim.x * NWAVES;
    constexpr int I_IN = 32 * 113, I_OUT = 32 * 32, NITEMS = DEPTH * (I_IN + I_OUT);
    bf16_t* W1T = (bf16_t*)(a->ws + WS_W1T); bf16_t* WVT = (bf16_t*)(a->ws + WS_WVT); bf16_t* WOT = (bf16_t*)(a->ws + WS_WOT);
    convert_layer(a, 0, lds, gw, NGW);
    { const int tid = blockIdx.x * NTHR + tid0, NT = gridDim.x * NTHR; constexpr int PADV = 240 * DM / 8;
      for (int i = tid; i < DEPTH * PADV; i += NT) { const int l = i / PADV, r = i % PADV; *((u32x4*)(W1T + (size_t)l * LDZ * DM + (size_t)(ZGA + 16) * DM) + r) = (u32x4){0u, 0u, 0u, 0u}; }
    }
    if (blockIdx.x == 0) { for (int i = tid0; i < 1024; i += NTHR) ((unsigned*)(a->ws + WS_CTR))[i] = 0u; }
    if (blockIdx.x == 1) { for (int i = tid0; i < (DEPTH * 32 + 2 * DEPTH) * 16; i += NTHR) ((unsigned*)(a->ws + WS_PCN))[i] = 0u; }
    rowpass0(a);
}

__device__ __forceinline__ void attn_naive_item(KArgs a, int l, int item) {
    const int tid = opaque_tid();
    const bf16_t* Z = (const bf16_t*)(a->ws + WS_Z1); const bf16_t* VT = (const bf16_t*)(a->ws + WS_VT); bf16_t* MB = (bf16_t*)(a->ws + WS_MB);
    const int h = item & 7, c = (item >> 3) & 31, b = item >> 8;
    const int qi = tid >> 3, dp = tid & 7;
    const int tokq = b * SEQ + c * CHUNK + qi;
    const float* rb = a->rel_bias + ((size_t)l * 8 + h) * 257;
    float q[16], acc[16];
#pragma unroll
    for (int i = 0; i < 16; ++i) { q[i] = bf2f(Z[(size_t)tokq * LDZ + ZAQ + h * 128 + dp * 16 + i]); acc[i] = 0.f; }
    float mx = -1e30f, ls = 0.f;
    const int kc0 = c - 8 < 0 ? 0 : c - 8;
    for (int kc = kc0; kc <= c; ++kc)
        for (int j = 0; j < CHUNK; ++j) {
            const int tokk = b * SEQ + kc * CHUNK + j;
            const bf16_t* kr = Z + (size_t)tokk * LDZ + ZAK + h * 128 + dp * 16;
            float s = 0.f;
#pragma unroll
            for (int i = 0; i < 16; ++i) s += q[i] * bf2f(kr[i]);
            s += __shfl_xor(s, 1); s += __shfl_xor(s, 2); s += __shfl_xor(s, 4);
            int rel = (c - kc) * CHUNK + qi - j; rel = rel > 128 ? 128 : (rel < -128 ? -128 : rel);
            s = s * 0.08838834764831845f + rb[rel + 128];
            const float mn = fmaxf(mx, s), corr = __expf(mx - mn), p = __expf(s - mn);
            ls = ls * corr + p; mx = mn;
#pragma unroll
            for (int i = 0; i < 16; ++i) acc[i] = acc[i] * corr + p * bf2f(VT[(size_t)(1024 + h * 128 + dp * 16 + i) * NTOK + tokk]);
        }
    float ss = 0.f; const float inv = 1.0f / ls;
#pragma unroll
    for (int i = 0; i < 16; ++i) { acc[i] *= inv; ss += acc[i] * acc[i]; }
    ss += __shfl_xor(ss, 1); ss += __shfl_xor(ss, 2); ss += __shfl_xor(ss, 4);
    const float rstd = rsqrtf(ss * (1.0f / 128.0f) + EPS);
#pragma unroll
    for (int i = 0; i < 16; ++i) { const int d = h * 128 + dp * 16 + i;
        const float g = a->g_att[(size_t)l * 1024 + d], gate = bf2f(Z[(size_t)tokq * LDZ + ZAG + d]);
        MB[(size_t)tokq * DM + 1024 + d] = (bf16_t)f2bf(acc[i] * rstd * g * silu_f(gate)); }
}
__device__ __forceinline__ void gla_naive_item(KArgs a, int l, int item, LAS unsigned char* lds) {
    const int tid = opaque_tid();
    const bf16_t* Z = (const bf16_t*)(a->ws + WS_Z1); const bf16_t* VT = (const bf16_t*)(a->ws + WS_VT); float* OR = (float*)(a->ws + WS_ORAW);
    LAS float* L = (LAS float*)lds;
    LAS float* S = L + 64 * 128;
    const int vt = item & 15, h = (item >> 4) & 3, b = item >> 6;
    for (int i = tid; i < 128 * 16; i += NTHR) S[i] = 0.f;
    float wal[16]; float bal = 0.f;
    if (tid < 128) { for (int r = 0; r < 16; ++r) wal[r] = a->w_alpha[((size_t)l * 16 + r) * 512 + h * 128 + tid]; bal = a->b_alpha[(size_t)l * 512 + h * 128 + tid]; }
    __syncthreads();
    for (int c = 0; c < NCH; ++c) {
        const int tok0 = b * SEQ + c * CHUNK;
        if (tid < 128) { float cum = 0.f;
            for (int s = 0; s < CHUNK; ++s) { const bf16_t* gr = Z + (size_t)(tok0 + s) * LDZ + ZGA; float x = bal;
#pragma unroll
                for (int r = 0; r < 16; ++r) x += bf2f(gr[r]) * wal[r];
                cum += logsigmoid_f(x) * (1.0f / 16.0f); L[s * 128 + tid] = cum; } }
        __syncthreads();
        { const int k = tid & 127, vq = tid >> 7; const float Le = L[63 * 128 + k], Ae = __expf(Le);
          float acc[4];
#pragma unroll
          for (int i = 0; i < 4; ++i) acc[i] = S[k * 16 + vq * 4 + i] * Ae;
          for (int s = 0; s < CHUNK; ++s) { const float kd = bf2f(Z[(size_t)(tok0 + s) * LDZ + ZGK + h * 128 + k]) * __expf(Le - L[s * 128 + k]);
#pragma unroll
              for (int i = 0; i < 4; ++i) acc[i] += kd * bf2f(VT[(size_t)(h * 256 + vt * 16 + vq * 4 + i) * NTOK + tok0 + s]); }
#pragma unroll
          for (int i = 0; i < 4; ++i) S[k * 16 + vq * 4 + i] = acc[i]; }
        __syncthreads();
        { const int s = tid >> 3, v2 = (tid & 7) * 2; float o0 = 0.f, o1 = 0.f; const bf16_t* qr = Z + (size_t)(tok0 + s) * LDZ + ZGQ + h * 128;
          for (int k = 0; k < 128; ++k) { const float qv = bf2f(qr[k]); o0 += qv * S[k * 16 + v2]; o1 += qv * S[k * 16 + v2 + 1]; }
          float* op = OR + (size_t)(tok0 + s) * 1024 + h * 256 + vt * 16 + v2; op[0] = o0 * 0.08838834764831845f; op[1] = o1 * 0.08838834764831845f; }
        __syncthreads();
    }
}
__device__ __forceinline__ void gla_norm_phase(KArgs a, int l) {
    const int tid = opaque_tid(), lane = tid & 63, gw = blockIdx.x * NWAVES + (tid >> 6), NGW = gridDim.x * NWAVES;
    const bf16_t* Z = (const bf16_t*)(a->ws + WS_Z1); const float* OR = (const float*)(a->ws + WS_ORAW); bf16_t* MB = (bf16_t*)(a->ws + WS_MB);
    for (int it = gw; it < NTOK * 4; it += NGW) { const int tok = it >> 2, h = it & 3;
        const f32x4 o = *((const f32x4*)(OR + (size_t)tok * 1024 + h * 256) + lane);
        const float ss = wave_sum((o[0] * o[0] + o[1] * o[1]) + (o[2] * o[2] + o[3] * o[3]));
        const float rstd = rsqrtf(ss * (1.0f / 256.0f) + EPS);
        const f32x4 g = *((const f32x4*)(a->g_gla + (size_t)l * 1024 + h * 256) + lane);
        const bf16_t* gg = Z + (size_t)tok * LDZ + ZGG + h * 256 + lane * 4;
        u32x2 w; w.x = pk2(o[0] * rstd * g[0] * silu_f(bf2f(gg[0])), o[1] * rstd * g[1] * silu_f(bf2f(gg[1])));
        w.y = pk2(o[2] * rstd * g[2] * silu_f(bf2f(gg[2])), o[3] * rstd * g[3] * silu_f(bf2f(gg[3])));
        *((u32x2*)(MB + (size_t)tok * DM + h * 256) + lane) = w; }
}


constexpr int AT_KS = 0, AT_VS = 34816, AT_PS = 71680, AT_BIAS = 90112;
__device__ __forceinline__ void attn_item(KArgs a, int l, int item, LAS unsigned char* lds) {
    const int tid = opaque_tid();
    const bf16_t* Z = (const bf16_t*)(a->ws + WS_Z1); const bf16_t* VT = (const bf16_t*)(a->ws + WS_VT); bf16_t* MB = (bf16_t*)(a->ws + WS_MB);
    const int hp = item & 3, c = (item >> 2) & 31, b = item >> 7;
    const int lane = tid & 63, w = __builtin_amdgcn_readfirstlane(tid >> 6), hh = w >> 2, wq = w & 3, h = 2 * hp + hh;
    const int l15 = lane & 15, lg = lane >> 4;
    const int tq0 = b * SEQ + c * CHUNK;
    bf16x8 qf[4];
    { const bf16_t* qp = Z + zaddr(tq0 + wq * 16 + l15, ZAQ + h * 128 + 8 * lg);
#pragma unroll
      for (int j = 0; j < 4; ++j) qf[j] = *(const bf16x8*)(qp + 32 * j); }
    f32x4 o[8]; float mrow = -1e30f, lsum = 0.f;
#pragma unroll
    for (int i = 0; i < 8; ++i) o[i] = (f32x4){0.f, 0.f, 0.f, 0.f};
    const int kc0 = c - 8 < 0 ? 0 : c - 8;
    const bf16_t* kg = Z + zaddr(b * SEQ + (tid >> 5), ZAK + 2 * hp * 128 + (tid & 31) * 8);
    const bf16_t* vg = VT + vaddr(1024 + 2 * hp * 128 + (tid >> 3), b * SEQ + (tid & 7) * 8);
    const int kl = AT_KS + ((((tid & 31) >> 4) * 64 + (tid >> 5)) * 136 + ((tid & 31) & 15) * 8) * 2;
    const int vl = AT_VS + ((tid >> 3) * 72 + (tid & 7) * 8) * 2;
    u32x4 kreg[4], vreg[4];
#pragma unroll
    for (int i = 0; i < 4; ++i) { kreg[i] = *(const u32x4*)(kg + (size_t)(kc0 * CHUNK + 16 * i) * 128); vreg[i] = *(const u32x4*)(vg + (size_t)(64 * i) * 64 + (size_t)kc0 * NVT * 64); }
    const LAS float* bt = (const LAS float*)(lds + AT_BIAS) + hh * 260;
    constexpr float SC2 = 0.08838834764831845f * 1.4426950408889634f;
    const int qi = wq * 16 + l15;
    for (int kc = kc0; kc <= c; ++kc) {
        __syncthreads();
#pragma unroll
        for (int i = 0; i < 4; ++i) { *(LAS u32x4*)(lds + kl + i * 16 * 136 * 2) = kreg[i]; *(LAS u32x4*)(lds + vl + i * 64 * 72 * 2) = vreg[i]; }
        if (kc == kc0) { for (int i = tid; i < 2 * 257; i += NTHR) { const int hb = i / 257, r = i % 257; ((LAS float*)(lds + AT_BIAS))[hb * 260 + r] = a->rel_bias[((size_t)l * 8 + 2 * hp + hb) * 257 + r] * 1.4426950408889634f; } }
        __syncthreads();
        if (kc < c) {
#pragma unroll
            for (int i = 0; i < 4; ++i) { kreg[i] = *(const u32x4*)(kg + (size_t)((kc + 1) * CHUNK + 16 * i) * 128); vreg[i] = *(const u32x4*)(vg + (size_t)(64 * i) * 64 + (size_t)(kc + 1) * NVT * 64); }
        }
        f32x4 s[4];
        { const LAS unsigned char* kb_ = lds + AT_KS + ((hh * 64 + l15) * 136 + 8 * lg) * 2;
#pragma unroll
          for (int nh = 0; nh < 2; ++nh) { bf16x8 kf[2][4];
#pragma unroll
              for (int n2 = 0; n2 < 2; ++n2)
#pragma unroll
                  for (int j = 0; j < 4; ++j) kf[n2][j] = *(const LAS bf16x8*)(kb_ + (2 * nh + n2) * (16 * 136 * 2) + 64 * j);
              __builtin_amdgcn_sched_barrier(0);
#pragma unroll
              for (int n2 = 0; n2 < 2; ++n2) { f32x4 acc_ = (f32x4){0.f, 0.f, 0.f, 0.f};
#pragma unroll
                  for (int j = 0; j < 4; ++j) acc_ = __builtin_amdgcn_mfma_f32_16x16x32_bf16(kf[n2][j], qf[j], acc_, 0, 0, 0);
                  s[2 * nh + n2] = acc_; }
              __builtin_amdgcn_sched_barrier(0); } }
        float mloc = -1e30f;
        if (c - kc >= 3) {
            const float bc = bt[256];
#pragma unroll
            for (int n = 0; n < 4; ++n)
#pragma unroll
                for (int r = 0; r < 4; ++r) { s[n][r] = s[n][r] * SC2 + bc; mloc = fmaxf(mloc, s[n][r]); }
        } else {
            const int relbase = (c - kc) * CHUNK + qi - 4 * lg;
#pragma unroll
            for (int n = 0; n < 4; ++n)
#pragma unroll
                for (int r = 0; r < 4; ++r) { int rel = relbase - 16 * n - r; rel = rel > 128 ? 128 : (rel < -128 ? -128 : rel);
                    s[n][r] = s[n][r] * SC2 + bt[rel + 128]; mloc = fmaxf(mloc, s[n][r]); }
        }
        mloc = fmaxf(mloc, __shfl_xor(mloc, 16)); mloc = fmaxf(mloc, __shfl_xor(mloc, 32));
        const float mn = fmaxf(mrow, mloc), corr = __builtin_amdgcn_exp2f(mrow - mn); mrow = mn; lsum *= corr;
        bf16x8 pf[2];
#pragma unroll
        for (int t = 0; t < 2; ++t) { float pv[8];
#pragma unroll
            for (int e = 0; e < 8; ++e) { pv[e] = __builtin_amdgcn_exp2f(s[2 * t + (e >> 2)][e & 3] - mrow); lsum += pv[e]; }
            const u32x4 pw4 = (u32x4){pk2(pv[0], pv[1]), pk2(pv[2], pv[3]), pk2(pv[4], pv[5]), pk2(pv[6], pv[7])};
            pf[t] = __builtin_bit_cast(bf16x8, pw4); }
#pragma unroll
        for (int nd = 0; nd < 8; ++nd) o[nd] *= corr;
        { const LAS unsigned char* vb_ = lds + AT_VS + ((hh * 128 + l15) * 72 + 4 * lg) * 2;
#pragma unroll
          for (int nq = 0; nq < 2; ++nq) { u32x4 vv[4][2];
#pragma unroll
              for (int n4 = 0; n4 < 4; ++n4)
#pragma unroll
                  for (int t = 0; t < 2; ++t) { const LAS unsigned char* vp_ = vb_ + (4 * nq + n4) * (16 * 72 * 2) + 64 * t;
                      const u32x2 va = *(const LAS u32x2*)vp_, vb = *(const LAS u32x2*)(vp_ + 32); vv[n4][t] = (u32x4){va.x, va.y, vb.x, vb.y}; }
              __builtin_amdgcn_sched_barrier(0);
#pragma unroll
              for (int n4 = 0; n4 < 4; ++n4)
#pragma unroll
                  for (int t = 0; t < 2; ++t) o[4 * nq + n4] = __builtin_amdgcn_mfma_f32_16x16x32_bf16(__builtin_bit_cast(bf16x8, vv[n4][t]), pf[t], o[4 * nq + n4], 0, 0, 0);
              __builtin_amdgcn_sched_barrier(0); } }
    }
    float lt = lsum; lt += __shfl_xor(lt, 16); lt += __shfl_xor(lt, 32);
    const float inv = 1.0f / lt; float ss = 0.f;
#pragma unroll
    for (int nd = 0; nd < 8; ++nd)
#pragma unroll
        for (int r = 0; r < 4; ++r) { o[nd][r] *= inv; ss += o[nd][r] * o[nd][r]; }
    ss += __shfl_xor(ss, 16); ss += __shfl_xor(ss, 32);
    const float rstd = rsqrtf(ss * (1.0f / 128.0f) + EPS); const int tok = tq0 + qi;
#pragma unroll
    for (int nd = 0; nd < 8; ++nd) { const int d = h * 128 + 16 * nd + 4 * lg;
        const f32x4 g = *(const f32x4*)(a->g_att + (size_t)l * 1024 + d); const u32x2 gw = *(const u32x2*)(Z + zaddr(tok, ZAG + d));
        const float g0 = __uint_as_float(gw.x << 16), g1 = __uint_as_float(gw.x & 0xffff0000u), g2 = __uint_as_float(gw.y << 16), g3 = __uint_as_float(gw.y & 0xffff0000u);
        u32x2 ow; ow.x = pk2(o[nd][0] * rstd * g[0] * silu_f(g0), o[nd][1] * rstd * g[1] * silu_f(g1)); ow.y = pk2(o[nd][2] * rstd * g[2] * silu_f(g2), o[nd][3] * rstd * g[3] * silu_f(g3));
        *(u32x2*)(MB + (size_t)tok * DM + 1024 + d) = ow; }
}

constexpr int GL_GA = 0, GL_TOT = 4096, GL_ST = 8192, GL_O = 8192 + 17408;
__device__ __forceinline__ void gla_prep_item(KArgs a, int l, int item, LAS unsigned char* lds) {
    const int tid = opaque_tid();
    const bf16_t* Z = (const bf16_t*)(a->ws + WS_Z1); bf16_t* KD = (bf16_t*)(a->ws + WS_KD) + (size_t)item * 8192; float* AD = (float*)(a->ws + WS_AD) + (size_t)item * 128;
    const int c = item & 31, h = (item >> 5) & 3, b = item >> 7;
    const int pk = tid & 127, sq = tid >> 7, tok0 = b * SEQ + c * CHUNK;
    float wal[16];
#pragma unroll
    for (int r = 0; r < 16; ++r) wal[r] = a->w_alpha[((size_t)l * 16 + r) * 512 + h * 128 + pk];
    const float bal = a->b_alpha[(size_t)l * 512 + h * 128 + pk];
    const unsigned ga2 = *(const unsigned*)(Z + zaddr(tok0 + (tid >> 3), ZGA + (tid & 7) * 2));
    bf16_t kv[16];
#pragma unroll
    for (int i = 0; i < 16; ++i) kv[i] = Z[zaddr(tok0 + 16 * sq + i, ZGK + h * 128 + pk)];
    LAS float* gaS = (LAS float*)(lds + GL_GA); LAS float* tot = (LAS float*)(lds + GL_TOT);
    __syncthreads();
    gaS[(tid >> 3) * 16 + (tid & 7) * 2] = __uint_as_float(ga2 << 16); gaS[(tid >> 3) * 16 + (tid & 7) * 2 + 1] = __uint_as_float(ga2 & 0xffff0000u);
    __syncthreads();
    float Lloc[16]; float cum = 0.f;
#pragma unroll
    for (int i = 0; i < 16; ++i) { const LAS f32x4* gr = (const LAS f32x4*)(gaS + (16 * sq + i) * 16); float x = bal;
#pragma unroll
        for (int r4 = 0; r4 < 4; ++r4) { const f32x4 g4 = gr[r4]; x += g4[0] * wal[4 * r4] + g4[1] * wal[4 * r4 + 1] + g4[2] * wal[4 * r4 + 2] + g4[3] * wal[4 * r4 + 3]; }
        cum += logsigmoid_fast(x) * (1.0f / 16.0f); Lloc[i] = cum; }
    tot[sq * 128 + pk] = cum;
    __syncthreads();
    float off = 0.f, Lend = 0.f;
#pragma unroll
    for (int q = 0; q < 4; ++q) { const float t = tot[q * 128 + pk]; off += (q < sq) ? t : 0.f; Lend += t; }
    unsigned wd[8];
#pragma unroll
    for (int i = 0; i < 8; ++i) wd[i] = pk2(bf2f(kv[2 * i]) * __expf(Lend - (off + Lloc[2 * i])), bf2f(kv[2 * i + 1]) * __expf(Lend - (off + Lloc[2 * i + 1])));
    *(u32x4*)(KD + pk * 64 + 16 * sq) = (u32x4){wd[0], wd[1], wd[2], wd[3]};
    *(u32x4*)(KD + pk * 64 + 16 * sq + 8) = (u32x4){wd[4], wd[5], wd[6], wd[7]};
    if (sq == 0) AD[pk] = __expf(Lend);
}
struct GlaK { u32x4 k0, k1, v0; };
struct GlaQ { bf16x8 qf[4]; };
constexpr int GL_ADT = 8192;
constexpr int GL_ST0 = GL_ADT + 16384, GL_STB = 17408;
constexpr int GL_O0 = GL_ST0 + 2 * GL_STB, GL_OB = 16640; constexpr int GL_KV0 = GL_O0 + 2 * GL_OB, GL_KVB = 27648;
__device__ __forceinline__ float fast_silu(float x) { return x * __builtin_amdgcn_rcpf(1.0f + __expf(-x)); }
__device__ __forceinline__ void gla_chain(KArgs a, int l, int item, LAS unsigned char* lds) {
    const int tid = opaque_tid(), lane = tid & 63, w = __builtin_amdgcn_readfirstlane(tid >> 6);
    const bf16_t* Z = (const bf16_t*)(a->ws + WS_Z1); const bf16_t* VT = (const bf16_t*)(a->ws + WS_VT); bf16_t* MB = (bf16_t*)(a->ws + WS_MB); float* SSP = (float*)(a->ws + WS_SSP);
    const int j = item & 3, h = (item >> 2) & 3, b = item >> 4;
    const int kt = w >> 1, vt = w & 1, l31 = lane & 31, lh = lane >> 5;
    const int sti = w & 3, vh = w >> 2, l15 = lane & 15, lg = lane >> 4;
    const int es = tid >> 3, evq = tid & 7;
    const bf16_t* kp = (const bf16_t*)(a->ws + WS_KD) + (size_t)((b * 4 + h) * 32) * 8192 + (tid >> 3) * 64 + (tid & 7) * 8;
    const bf16_t* vp = VT + vaddr(h * 256 + 64 * j + (tid >> 3), b * SEQ + (tid & 7) * 8);
    const int kvw = ((tid >> 3) * 72 + (tid & 7) * 8) * 2;
    const int kur = ((32 * kt + l31) * 72 + 8 * lh) * 2, vur = 18432 + ((32 * vt + l31) * 72 + 8 * lh) * 2;
    const bf16_t* qp = Z + zaddr(b * SEQ + 16 * sti + l15, ZGQ + h * 128 + 8 * lg);
    const bf16_t* gp = Z + zaddr(b * SEQ + es, ZGG + h * 256 + 64 * j + 8 * evq);
    bf16_t* mp = MB + (size_t)(b * SEQ + es) * DM + h * 256 + 64 * j + 8 * evq;
    float* sp = SSP + ((size_t)(b * SEQ + es) * 4 + h) * 4 + j;
#define GLA_LDK(dst) do { (dst).k0 = *(const u32x4*)kp; (dst).k1 = *(const u32x4*)(kp + 64 * 64); (dst).v0 = *(const u32x4*)vp; kp += 8192; vp += (size_t)NVT * 64; } while (0)
#define GLA_STK(src, buf) do { LAS unsigned char* kb_ = lds + GL_KV0 + (buf) * GL_KVB + kvw; asm volatile("" : "+v"(kb_)); \
        *(LAS u32x4*)kb_ = (src).k0; *(LAS u32x4*)(kb_ + 64 * 72 * 2) = (src).k1; *(LAS u32x4*)(kb_ + 18432) = (src).v0; } while (0)
#define GLA_LDQ(dst) do { _Pragma("unroll") for (int i_ = 0; i_ < 4; ++i_) (dst).qf[i_] = *(const bf16x8*)(qp + 32 * i_); qp += (size_t)CHUNK * 128; } while (0)
    GlaK K0, K1, K2; GlaQ Q0, Q1, Q2; u32x4 G0, G1, G2;
    GLA_LDK(K0); GLA_LDK(K1); GLA_LDK(K2); GLA_LDQ(Q0);
    G0 = G1 = G2 = (u32x4){0u, 0u, 0u, 0u}; Q1 = Q0; Q2 = Q0;
    GLA_STK(K0, 0); GLA_LDK(K0);
    float gl[8];
    { const f32x4* gg4 = (const f32x4*)(a->g_gla + (size_t)l * 1024 + h * 256 + 64 * j + 8 * evq); const f32x4 ga_ = gg4[0], gb_ = gg4[1];
      gl[0] = ga_[0]; gl[1] = ga_[1]; gl[2] = ga_[2]; gl[3] = ga_[3]; gl[4] = gb_[0]; gl[5] = gb_[1]; gl[6] = gb_[2]; gl[7] = gb_[3]; }
    { const f32x4* adg = (const f32x4*)((const float*)(a->ws + WS_AD) + (size_t)((b * 4 + h) * 32) * 128); LAS f32x4* adl = (LAS f32x4*)(lds + GL_ADT);
      adl[tid] = adg[tid]; adl[tid + 512] = adg[tid + 512]; }
    f32x16 S;
#pragma unroll
    for (int i = 0; i < 16; ++i) S[i] = 0.f;
    __syncthreads();
#define GLA_ITER(i, DO_LD, DO_U, DO_O, DO_E, KU, KL, QU, QL, GU, GL_) do { const int i_t = (i); \
        if (DO_LD) { GLA_STK(KL, (i_t + 1) & 1); GLA_LDK(KL); GLA_LDQ(QL); GL_ = *(const u32x4*)gp; gp += (size_t)CHUNK * 128; }     \
        if (DO_U) {                                                                          \
            _Pragma("unroll") for (int rg = 0; rg < 4; ++rg) { const f32x4 ad = *(const LAS f32x4*)(lds + GL_ADT + (i_t * 128 + 32 * kt + 8 * rg + 4 * lh) * 4); \
                _Pragma("unroll") for (int q_ = 0; q_ < 4; ++q_) S[4 * rg + q_] *= ad[q_]; } \
            { LAS unsigned char* kvb_ = lds + GL_KV0 + (i_t & 1) * GL_KVB; asm volatile("" : "+v"(kvb_)); bf16x8 kf_[4], vf_[4]; \
              _Pragma("unroll") for (int ss = 0; ss < 4; ++ss) { kf_[ss] = *(const LAS bf16x8*)(kvb_ + kur + 32 * ss); vf_[ss] = *(const LAS bf16x8*)(kvb_ + vur + 32 * ss); } \
              _Pragma("unroll") for (int ss = 0; ss < 4; ++ss) S = __builtin_amdgcn_mfma_f32_32x32x16_bf16(kf_[ss], vf_[ss], S, 0, 0, 0); } \
            LAS unsigned char* sw_ = lds + GL_ST0 + (i_t & 1) * GL_STB + ((32 * vt + l31) * 136 + 32 * kt + 4 * lh) * 2; asm volatile("" : "+v"(sw_));     \
            _Pragma("unroll") for (int rg = 0; rg < 4; ++rg) { u32x2 wv; wv.x = pg8::cvt_pk_bf16(S[4 * rg], S[4 * rg + 1]); wv.y = pg8::cvt_pk_bf16(S[4 * rg + 2], S[4 * rg + 3]); \
                *(LAS u32x2*)(sw_ + 16 * rg) = wv; } } \
        if (DO_O) {                                                                          \
            f32x4 oa[2] = {(f32x4){0.f, 0.f, 0.f, 0.f}, (f32x4){0.f, 0.f, 0.f, 0.f}}; \
            LAS unsigned char* sr_ = lds + GL_ST0 + ((i_t - 1) & 1) * GL_STB + ((32 * vh + l15) * 136 + 8 * lg) * 2; asm volatile("" : "+v"(sr_)); \
            bf16x8 bfr[4][2]; \
            _Pragma("unroll") for (int kk = 0; kk < 4; ++kk) \
                _Pragma("unroll") for (int t = 0; t < 2; ++t) bfr[kk][t] = *(const LAS bf16x8*)(sr_ + t * (16 * 136 * 2) + kk * 64); \
            __builtin_amdgcn_sched_barrier(0);                                               \
            _Pragma("unroll") for (int kk = 0; kk < 4; ++kk) \
                _Pragma("unroll") for (int t = 0; t < 2; ++t) oa[t] = __builtin_amdgcn_mfma_f32_16x16x32_bf16((QU).qf[kk], bfr[kk][t], oa[t], 0, 0, 0); \
            LAS float* oS_ = (LAS float*)(lds + GL_O0 + ((i_t - 1) & 1) * GL_OB) + (16 * sti + 4 * lg) * 65 + 32 * vh + l15; asm volatile("" : "+v"(oS_)); \
            _Pragma("unroll") for (int t = 0; t < 2; ++t) \
                _Pragma("unroll") for (int r = 0; r < 4; ++r) oS_[r * 65 + 16 * t] = oa[t][r] * 0.08838834764831845f; } \
        if (DO_E) {                                                                          \
            const LAS float* oS_ = (const LAS float*)(lds + GL_O0 + (i_t & 1) * GL_OB) + es * 65 + 8 * evq; asm volatile("" : "+v"(oS_)); float ov[8]; float ss = 0.f; \
            _Pragma("unroll") for (int q_ = 0; q_ < 8; ++q_) { ov[q_] = oS_[q_]; ss += ov[q_] * ov[q_]; } \
            ss += __builtin_bit_cast(float, __builtin_amdgcn_mov_dpp(__builtin_bit_cast(int, ss), 0xB1, 0xF, 0xF, true));      \
            ss += __builtin_bit_cast(float, __builtin_amdgcn_mov_dpp(__builtin_bit_cast(int, ss), 0x4E, 0xF, 0xF, true));      \
            ss += __builtin_bit_cast(float, __builtin_amdgcn_mov_dpp(__builtin_bit_cast(int, ss), 0x141, 0xF, 0xF, true));     \
            if (evq == 0) *sp = ss; sp += CHUNK * 16; \
            const unsigned gw4[4] = {(GU).x, (GU).y, (GU).z, (GU).w}; unsigned ow[4]; \
            _Pragma("unroll") for (int q_ = 0; q_ < 4; ++q_) { const float g0 = __uint_as_float(gw4[q_] << 16), g1 = __uint_as_float(gw4[q_] & 0xffff0000u); \
                ow[q_] = pg8::cvt_pk_bf16(ov[2 * q_] * gl[2 * q_] * fast_silu(g0), ov[2 * q_ + 1] * gl[2 * q_ + 1] * fast_silu(g1)); } \
            *(u32x4*)mp = (u32x4){ow[0], ow[1], ow[2], ow[3]}; mp += (size_t)CHUNK * DM; } \
        asm volatile("s_waitcnt lgkmcnt(0)" ::: "memory"); __builtin_amdgcn_s_barrier(); asm volatile("" ::: "memory"); \
    } while (0)
    GLA_ITER(0, true, true, false, false, K0, K1, Q2, Q1, G1, G0); GLA_ITER(1, true, true, true, false, K1, K2, Q0, Q2, G2, G1);
#pragma nounroll
    for (int i = 2; i < 32; i += 3) { GLA_ITER(i, true, true, true, true, K2, K0, Q1, Q0, G0, G2); GLA_ITER(i + 1, true, true, true, true, K0, K1, Q2, Q1, G1, G0); GLA_ITER(i + 2, true, true, true, true, K1, K2, Q0, Q2, G2, G1); }
    GLA_ITER(32, false, false, true, true, K2, K1, Q1, Q0, G0, G2); GLA_ITER(33, false, false, false, true, K0, K2, Q2, Q1, G1, G0);
    __syncthreads();
#undef GLA_ITER
#undef GLA_LDK
#undef GLA_LDQ
}

#define XB_TMO      128
#define XB_XCNT(j)  (256  + 64 * (j))
#define XB_XSUB(j)  (1280 + 64 * (j))
#define XB_XGEN(j)  (2304 + 64 * (j))
#define XB_TOP      3328
#define XB_TOPGEN   3392
#define XCD_BAR_WORDS 3456
#define XB_SPIN_CAP (1u << 18)
__device__ __forceinline__ unsigned xb_ld(unsigned* p)              { return __hip_atomic_load(p, __ATOMIC_RELAXED, __HIP_MEMORY_SCOPE_AGENT); }
__device__ __forceinline__ unsigned xb_add(unsigned* p, unsigned v) { return __hip_atomic_fetch_add(p, v, __ATOMIC_RELAXED, __HIP_MEMORY_SCOPE_AGENT); }
__device__ __forceinline__ unsigned xb_xcc_id() { return (unsigned)__builtin_amdgcn_s_getreg((3 << 11) | 20) & 0xFu; }
#define XB_SPIN(cond, bar) do { unsigned _sp = 0; while (cond) { __builtin_amdgcn_s_sleep(1); \
    if ((++_sp & 255u) == 0u) { if (xb_ld(&(bar)[XB_TMO])) break; if (_sp > XB_SPIN_CAP) { atomicAdd(&(bar)[XB_TMO], 1u); break; } } } } while (0)
__device__ __forceinline__ void xcd_barrier_complete(unsigned* bar, unsigned x, unsigned& nloc, unsigned& nx) {
    const unsigned G = gridDim.x * gridDim.y * gridDim.z;
    unsigned sum, cnt, mine, sp = 0u;
    for (;;) {
        sum = 0u; cnt = 0u; mine = 0u;
#pragma unroll
        for (unsigned j = 0; j < 16; ++j) { const unsigned c = xb_ld(&bar[XB_XCNT(j)]); sum += c; cnt += (c > 0u) ? 1u : 0u; mine = (j == x) ? c : mine; }
        if (sum == G) break;
        __builtin_amdgcn_s_sleep(1);
        if ((++sp & 255u) == 0u) { if (xb_ld(&bar[XB_TMO])) break; if (sp > XB_SPIN_CAP) { atomicAdd(&bar[XB_TMO], 1u); break; } }
    }
    nloc = mine > 0u ? mine : 1u; nx = cnt > 0u ? cnt : 1u;
}
__device__ __forceinline__ void xcd_barrier(unsigned* bar, volatile LAS unsigned* st) {
    asm volatile("s_waitcnt vmcnt(0)" ::: "memory");
    __syncthreads();
    if (threadIdx.x == 0) {
        const unsigned x = xb_xcc_id();
        __builtin_amdgcn_s_waitcnt(0);
        unsigned nloc = st[0], nx = st[1];
        if (nloc == 0u) { xcd_barrier_complete(bar, x, nloc, nx); st[0] = nloc; st[1] = nx; }
        const unsigned old = xb_add(&bar[XB_XSUB(x)], 1u);
        const unsigned gen = old / nloc;
        if (old + 1u == (gen + 1u) * nloc) {
            __builtin_amdgcn_fence(__ATOMIC_RELEASE, "agent");
            asm volatile("s_waitcnt vmcnt(0)" ::: "memory");
            const unsigned og = xb_add(&bar[XB_TOP], 1u);
            const unsigned tg = og / nx;
            if (og + 1u == (tg + 1u) * nx) xb_add(&bar[XB_TOPGEN], 1u);
            else XB_SPIN(xb_ld(&bar[XB_TOPGEN]) == tg, bar);
            __builtin_amdgcn_fence(__ATOMIC_ACQUIRE, "agent");
            xb_add(&bar[XB_XGEN(x)], 1u);
            asm volatile("s_waitcnt vmcnt(0)" ::: "memory");
        } else {
            XB_SPIN(xb_ld(&bar[XB_XGEN(x)]) == gen, bar);
            __builtin_amdgcn_fence(__ATOMIC_ACQUIRE, "agent");
            asm volatile("s_waitcnt vmcnt(0)" ::: "memory");
        }
    }
    __syncthreads();
}
constexpr int LDS_XB = 159696;
#define GRID_BAR() xcd_barrier((unsigned*)(fresh_args()->ws + WS_BAR), (volatile LAS unsigned*)(lds + LDS_XB))

constexpr int NPHASES = 1 + 5 * DEPTH;
#ifndef PROBE
#define PROBE 0
#endif
__global__ void __launch_bounds__(NTHR) mk_fwd(Args a_unused) {
    extern __shared__ __attribute__((aligned(16))) unsigned char lds_raw[];
    LAS unsigned char* lds = (LAS unsigned char*)lds_raw;
    { unsigned* bar0 = (unsigned*)(fresh_args()->ws + WS_BAR);
      if (threadIdx.x == 0) { ((volatile LAS unsigned*)(lds + LDS_XB))[0] = 0u; ((volatile LAS unsigned*)(lds + LDS_XB))[1] = 0u;
        (void)xb_add(&bar0[XB_XCNT(xb_xcc_id())], 1u); } }
    __syncthreads();
#define IN(k) (fresh_args()->ph_lo <= (k) && (k) < fresh_args()->ph_hi)
#define SEAM(k) do { if (fresh_args()->coop && IN(k) && IN((k) + 1)) { GRID_BAR(); } } while (0)
    if (fresh_args()->coop == 2) cg::this_grid().sync();
    if (IN(0)) { p0_phase(fresh_args(), lds); }
    if (PROBE == 1) { for (int i = 0; i < 16; ++i) GRID_BAR(); }
    if (PROBE == 2) { cg::this_grid().sync(); p0_phase(fresh_args(), lds); }
    SEAM(0);
#pragma nounroll
    for (int l = 0; l < DEPTH; ++l) {
        const int pb = 1 + 5 * l;
        if (IN(pb)) for (int rep_ = 0; rep_ < (PROBE == 3 ? 2 : 1); ++rep_) {
            KArgs a = fresh_args();
            pg8::DualOrder SD; SD.s0.init(NTOK, LDZ, gridDim.x, blockIdx.x, 8); SD.s1.init(NVT, NTOK, gridDim.x, blockIdx.x, 8); SD.G = gridDim.x; SD.c = blockIdx.x;
            SD.A0 = (const bf16_t*)(a->ws + WS_H); SD.B0 = (const bf16_t*)(a->ws + WS_W1T) + (size_t)l * LDZ * DM;
            SD.A1 = (const bf16_t*)(a->ws + WS_WVT) + (size_t)l * DM * DM; SD.B1 = (const bf16_t*)(a->ws + WS_H);
            pg8::Gemm g1{SD.A0, SD.B0, NTOK, LDZ, DM};
            pg8::EpiBf16 E1{(bf16_t*)(a->ws + WS_Z1), -1, (const float*)(a->ws + WS_SS2), (bf16_t*)(a->ws + WS_VT)};
            pg8::gemm_phase<pg8::EpiBf16, pg8::DualOrder, false, true>(lds, g1, SD, E1);
            if (rep_ == 0 && l + 1 < DEPTH && blockIdx.x >= 160 && gridDim.x == 256) convert_layer(fresh_args(), l + 1, lds, (blockIdx.x - 160) * NWAVES + __builtin_amdgcn_readfirstlane(opaque_tid() >> 6), 96 * NWAVES);
            else if (rep_ == 0 && l + 1 < DEPTH && gridDim.x != 256) convert_layer(fresh_args(), l + 1, lds, blockIdx.x * NWAVES + __builtin_amdgcn_readfirstlane(opaque_tid() >> 6), gridDim.x * NWAVES);
        }
        SEAM(pb);
        if (IN(pb + 1)) for (int rep_ = 0; rep_ < (PROBE == 4 ? 2 : 1); ++rep_) {
#ifdef NAIVE_GLA
            for (int it = blockIdx.x; it < 512; it += gridDim.x) attn_item(fresh_args(), l, it, lds);
            for (int it = blockIdx.x; it < 256; it += gridDim.x) { __syncthreads(); gla_naive_item(fresh_args(), l, it, lds); }
#else
            const int x0 = blockIdx.x & 7;
            unsigned* evt = (unsigned*)(fresh_args()->ws + WS_PCN) + (DEPTH * 32 + l * 2 + rep_) * 16;
            const bool chainwg = blockIdx.x < 64 && gridDim.x == 256;
            if (!chainwg) {
                const int nprep = gridDim.x == 256 ? 192 : (int)gridDim.x, pid = gridDim.x == 256 ? (int)blockIdx.x - 64 : (int)blockIdx.x;
                for (int it = pid; it < 512; it += nprep) gla_prep_item(fresh_args(), l, it, lds);
                asm volatile("s_waitcnt vmcnt(0)" ::: "memory"); __syncthreads();
                if (threadIdx.x == 0) { __builtin_amdgcn_fence(__ATOMIC_RELEASE, "agent"); asm volatile("s_waitcnt vmcnt(0)" ::: "memory"); __hip_atomic_fetch_add(evt, 1u, __ATOMIC_RELAXED, __HIP_MEMORY_SCOPE_AGENT); }
            }
            if (gridDim.x != 256) { if (fresh_args()->coop) GRID_BAR(); }
            if (blockIdx.x < 64) {
                if (chainwg) {
                    unsigned* qh0 = (unsigned*)(fresh_args()->ws + WS_CTR) + ((l * 2 + rep_) * 8 + x0) * 16;
                    __syncthreads();
                    if (threadIdx.x == 0) { int q_ = 64; if (__hip_atomic_load(qh0, __ATOMIC_RELAXED, __HIP_MEMORY_SCOPE_AGENT) < 64u) q_ = (int)atomicAdd(qh0, 1u); *(LAS int*)(lds + 159680) = q_; }
                    __syncthreads();
                    const int q = *(LAS int*)(lds + 159680);
                    if (q < 64) { const int pair = 2 * x0 + (q & 1), c = 31 - (q >> 1); attn_item(fresh_args(), l, ((pair >> 2) << 7) | (c << 2) | (pair & 3), lds); }
                    __syncthreads();
                    if (threadIdx.x == 0) { unsigned sp = 0;
                        while (__hip_atomic_load(evt, __ATOMIC_RELAXED, __HIP_MEMORY_SCOPE_AGENT) < 192u) { __builtin_amdgcn_s_sleep(2); if (++sp > (1u << 22)) break; }
                        __builtin_amdgcn_fence(__ATOMIC_ACQUIRE, "agent"); asm volatile("s_waitcnt vmcnt(0)" ::: "memory"); }
                    __syncthreads();
                }
                const int idx = blockIdx.x >> 3; gla_chain(fresh_args(), l, ((2 * x0 + (idx >> 2)) << 2) | (idx & 3), lds);
            }
            for (int dx = 0; dx < 8; ++dx) {
                const int x = (x0 + dx) & 7;
                unsigned* qh = (unsigned*)(fresh_args()->ws + WS_CTR) + ((l * 2 + rep_) * 8 + x) * 16;
                for (;;) {
                    __syncthreads();
                    if (threadIdx.x == 0) { int q_ = 64; if (__hip_atomic_load(qh, __ATOMIC_RELAXED, __HIP_MEMORY_SCOPE_AGENT) < 64u) q_ = (int)atomicAdd(qh, 1u); *(LAS int*)(lds + 159680) = q_; }
                    __syncthreads();
                    const int q = *(LAS int*)(lds + 159680);
                    if (q >= 64) break;
                    const int pair = 2 * x + (q & 1), c = 31 - (q >> 1);
                    attn_item(fresh_args(), l, ((pair >> 2) << 7) | (c << 2) | (pair & 3), lds);
                }
            }
#endif
        }
        SEAM(pb + 1);
#ifdef NAIVE_GLA
        if (IN(pb + 2)) { gla_norm_phase(fresh_args(), l); }
#endif
        SEAM(pb + 2);
        if (IN(pb + 3)) for (int rep_ = 0; rep_ < (PROBE == 5 ? 2 : 1); ++rep_) {
            KArgs a = fresh_args();
            pg8::StaticOrder S3; S3.init(NTOK, DM, gridDim.x, blockIdx.x);
            { pg8::Unit u0; const int t3 = opaque_tid();
              if (S3.next(0, u0) && t3 < 256) { LAS float* tab = (LAS float*)(lds + 131072); float rr[4];
#ifdef NAIVE_GLA
#pragma unroll
                  for (int hq = 0; hq < 4; ++hq) rr[hq] = 1.0f;
#else
                  const f32x4* sp = (const f32x4*)((const float*)(a->ws + WS_SSP) + (size_t)(u0.pm * 256 + t3) * 16);
#pragma unroll
                  for (int hq = 0; hq < 4; ++hq) { const f32x4 p4 = sp[hq]; rr[hq] = rsqrtf(((p4[0] + p4[1]) + (p4[2] + p4[3])) * (1.0f / 256.0f) + EPS); }
#endif
                  tab[t3] = rr[0] / rr[1]; tab[256 + t3] = rr[1] / rr[2]; tab[512 + t3] = rr[2] / rr[3]; tab[768 + t3] = rr[3]; }
              __syncthreads(); }
            pg8::Gemm g3{(const bf16_t*)(a->ws + WS_MB), (const bf16_t*)(a->ws + WS_WOT) + (size_t)l * DM * DM, NTOK, DM, DM};
            pg8::EpiF32SS E3{l == 0 ? a->x : a->out, a->out, a->g_post + (size_t)l * DM, a->g_pre + (size_t)(l + 1 < DEPTH ? l + 1 : 0) * DM, (bf16_t*)(a->ws + WS_H),
                             (float*)(a->ws + WS_SSY), (float*)(a->ws + WS_SS2), (unsigned*)(a->ws + WS_PCN) + (size_t)l * 32 * 16, l + 1 < DEPTH ? 1 : 0};
            pg8::gemm_phase<pg8::EpiF32SS, pg8::StaticOrder>(lds, g3, S3, E3);
        }
        SEAM(pb + 3);
    }
#undef IN
#undef SEAM
}

extern "C" void kernel_launch(void* const* d_in, const int* in_sizes, int n_in, void* d_out, int out_size, void* d_ws, size_t ws_size, hipStream_t stream) {
    static int grid = 0;
    if (grid == 0) {
        if (n_in != 10 || out_size != NTOK * DM || ws_size < WS_END) { fprintf(stderr, "kernel_launch: unexpected shapes (n_in %d out %d ws %zu need %zu)\n", n_in, out_size, ws_size, (size_t)WS_END); grid = -1; return; }
        int dev = 0, cus = 0, per_cu = 0;
        (void)hipGetDevice(&dev); (void)hipDeviceGetAttribute(&cus, hipDeviceAttributeMultiprocessorCount, dev);
        (void)hipFuncSetAttribute((const void*)mk_fwd, hipFuncAttributeMaxDynamicSharedMemorySize, LDS_BYTES);
        (void)hipOccupancyMaxActiveBlocksPerMultiprocessor(&per_cu, (const void*)mk_fwd, NTHR, LDS_BYTES);
        if (per_cu < 1) { fprintf(stderr, "kernel_launch: occupancy query says %d blocks per CU\n", per_cu); per_cu = 1; }
        (void)hipGetLastError();
        grid = cus;
    }
    if (grid < 0) return;
    Args ka{};
    ka.x = (const float*)d_in[0]; ka.w_in = (const float*)d_in[1]; ka.w_out = (const float*)d_in[2]; ka.g_pre = (const float*)d_in[3]; ka.g_post = (const float*)d_in[4];
    ka.w_alpha = (const float*)d_in[5]; ka.b_alpha = (const float*)d_in[6]; ka.g_gla = (const float*)d_in[7]; ka.g_att = (const float*)d_in[8]; ka.rel_bias = (const float*)d_in[9];
    ka.out = (float*)d_out; ka.ws = (unsigned char*)d_ws; ka.pad = 0;
#if 0
    ka.coop = 0;
    for (int p = 0; p < NPHASES; ++p) { ka.ph_lo = p; ka.ph_hi = p + 1; hipLaunchKernelGGL(mk_fwd, dim3(grid), dim3(NTHR), LDS_BYTES, stream, ka); }
#else
    ka.coop = 1; ka.ph_lo = 0; ka.ph_hi = NPHASES;
    (void)hipMemsetAsync((char*)d_ws + WS_BAR, 0, XCD_BAR_WORDS * 4, stream);
    void* args[] = {&ka};
    hipError_t e = hipLaunchCooperativeKernel((const void*)mk_fwd, dim3(grid), dim3(NTHR), args, LDS_BYTES, stream);
    if (e != hipSuccess) fprintf(stderr, "cooperative launch failed: %s (grid %d)\n", hipGetErrorString(e), grid);
#endif
}
```

```cpp
#include <hip/hip_runtime.h>
#include <hip/hip_cooperative_groups.h>
#include <cstdio>
namespace cg = cooperative_groups;

#define LAS __attribute__((address_space(3)))
typedef unsigned short bf16_t;
typedef short bf16x8 __attribute__((ext_vector_type(8)));
typedef float f32x4 __attribute__((ext_vector_type(4)));
typedef unsigned u32x4 __attribute__((ext_vector_type(4)));
typedef unsigned u32x2 __attribute__((ext_vector_type(2)));
typedef float f32x16 __attribute__((ext_vector_type(16)));

constexpr int DM = 2048, NTOK = 8192, SEQ = 2048, DEPTH = 4, CHUNK = 64, NCH = 32;
constexpr int D_IN = 7184;
constexpr int LDZ = 5376;
constexpr int ZGQ = 0, ZGK = 512, ZGG = 1024, ZAQ = 2048, ZAK = 3072, ZAG = 4096, ZGA = 5120;
constexpr int NVT = 2048;
constexpr float EPS = 1e-6f;
__host__ __device__ __forceinline__ constexpr size_t zaddr(int tok, int col) { return (size_t)(col >> 7) * ((size_t)8192 * 128) + (size_t)tok * 128 + (col & 127); }
__host__ __device__ __forceinline__ constexpr size_t vaddr(int d, int tok) { return (size_t)(tok >> 6) * ((size_t)2048 * 64) + (size_t)d * 64 + (tok & 63); }
constexpr int NTHR = 512, NWAVES = 8;
constexpr int LDS_BYTES = 156 * 1024;

constexpr size_t SZ_W1T = (size_t)LDZ * DM * 2, SZ_WSQ = (size_t)DM * DM * 2;
constexpr size_t WS_W1T = 0;
constexpr size_t WS_WVT = WS_W1T + DEPTH * SZ_W1T;
constexpr size_t WS_WOT = WS_WVT + DEPTH * SZ_WSQ;
constexpr size_t WS_H   = WS_WOT + DEPTH * SZ_WSQ;
constexpr size_t WS_Z1  = WS_H + (size_t)NTOK * DM * 2;
constexpr size_t WS_VT  = WS_Z1 + (size_t)NTOK * LDZ * 2;
constexpr size_t WS_MB  = WS_VT + (size_t)NVT * NTOK * 2;
constexpr size_t WS_Y   = WS_MB + (size_t)NTOK * DM * 2;
constexpr size_t WS_ORAW = WS_Y + (size_t)NTOK * DM * 4;
constexpr size_t WS_RSS = WS_ORAW + (size_t)NTOK * 1024 * 4;
constexpr size_t WS_SSY = WS_RSS;
constexpr size_t WS_SS2 = WS_RSS + (size_t)NTOK * 8 * 4;
constexpr size_t WS_PCN = WS_RSS + (size_t)NTOK * 16 * 4;
constexpr size_t WS_SSP = WS_RSS + (size_t)NTOK * 32 * 4;
constexpr size_t WS_CTR = WS_SSP + (size_t)NTOK * 16 * 4;
constexpr size_t WS_KD = WS_CTR + 4096;
constexpr size_t WS_AD = WS_KD + (size_t)512 * 8192 * 2;
constexpr size_t WS_BAR = WS_AD + (size_t)512 * 128 * 4;
constexpr size_t WS_END = WS_BAR + 3456 * 4;

typedef float f32x2 __attribute__((ext_vector_type(2)));
typedef __bf16 bf16x2_t __attribute__((ext_vector_type(2)));
__device__ __forceinline__ unsigned pk2(float lo, float hi) { const f32x2 v = {lo, hi}; const bf16x2_t r = __builtin_convertvector(v, bf16x2_t); return __builtin_bit_cast(unsigned, r); }
__device__ __forceinline__ unsigned f2bf(float f) { return pk2(f, 0.f) & 0xffffu; }
__device__ __forceinline__ float bf2f(bf16_t b) { return __uint_as_float(((unsigned)b) << 16); }
__device__ __forceinline__ float wave_sum(float v) {
#pragma unroll
    for (int o = 1; o < 64; o <<= 1) v += __shfl_xor(v, o);
    return v;
}
__device__ __forceinline__ float silu_f(float x) { return x / (1.0f + __expf(-x)); }
__device__ __forceinline__ float logsigmoid_f(float x) { return fminf(x, 0.f) - log1pf(__expf(-fabsf(x))); }
__device__ __forceinline__ float logsigmoid_fast(float x) { return fminf(x, 0.f) - __logf(1.0f + __expf(-fabsf(x))); }
__device__ __forceinline__ int opaque_tid() { int t = threadIdx.x; asm volatile("" : "+v"(t)); return t; }
#define LDS_WAIT() asm volatile("s_waitcnt lgkmcnt(0)" ::: "memory")

namespace pg8 {
#define PG8_LAS __attribute__((address_space(3)))
constexpr int BM = 256, BK = 64, HALF = 128, HTB = HALF * BK * 2, STAGE_BYTES = 8 * HTB, NXCD = 8, WGM = 2;
__host__ __device__ __forceinline__ int lds_byte(int r, int c) { const int st = (r >> 4) * 2 + (c >> 5), rr = r & 15, cc = c & 31, ob = rr * 64 + cc * 2; return st * 1024 + (ob ^ (((ob >> 9) & 1) << 5)); }
__host__ __device__ __forceinline__ void stage_rc(int b, int& R, int& C) { const int st = b / 1024, sb = b % 1024, swz = sb ^ (((sb >> 9) & 1) << 5); R = (st >> 1) * 16 + swz / 64; C = (st & 1) * 32 + (swz % 64) / 2; }
__host__ __device__ __forceinline__ int perm32(int rho) { const int n = rho >> 4, i = rho & 15; return 8 * (i >> 2) + 4 * n + (i & 3); }
struct Unit { int pm, pn, which; };
struct Gemm { const bf16_t* A; const bf16_t* Bt; int M, N, K; };
struct StaticOrder {
    int nM, nN, nwg, G, c, wgm;
    __host__ __device__ void init(int M, int N, int G_, int c_, int wgm_ = WGM) { nM = M / BM; nN = N / BM; nwg = nM * nN; G = G_; c = c_; wgm = wgm_; }
    __host__ __device__ bool next(int i, Unit& u) const { const long L = (long)i * G + c; if (L >= nwg) return false; u.which = 0; decode((int)L, u); return true; }
    __device__ __forceinline__ const bf16_t* opA(const Gemm& g, const Unit&) const { return g.A; }
    __device__ __forceinline__ const bf16_t* opB(const Gemm& g, const Unit&) const { return g.Bt; }
    __host__ __device__ void decode(int L, Unit& u) const {
        int wgid = L; { const int q = nwg / NXCD, r = nwg % NXCD, xcd = wgid % NXCD, off = wgid / NXCD; wgid = (xcd < r ? xcd * (q + 1) : r * (q + 1) + (xcd - r) * q) + off; }
        const int nig = wgm * nN, gid = wgid / nig, fm = gid * wgm, gsz = (nM - fm) < wgm ? (nM - fm) : wgm;
        u.pm = fm + ((wgid % nig) % gsz); u.pn = (wgid % nig) / gsz;
    }
    __device__ __forceinline__ void a_ready(const Unit&) const {}
    __device__ __forceinline__ void done(const Unit&) const {}
};
struct DualOrder {
    StaticOrder s0, s1; const bf16_t *A0, *B0, *A1, *B1; int G, c;
    __host__ __device__ bool next(int i, Unit& u) const { const long L = (long)i * G + c; if (L >= s0.nwg + s1.nwg) return false;
        if (L < s0.nwg) { u.which = 0; s0.decode((int)L, u); } else { u.which = 1; s1.decode((int)L - s0.nwg, u); } return true; }
    __device__ __forceinline__ const bf16_t* opA(const Gemm&, const Unit& u) const { return u.which ? A1 : A0; }
    __device__ __forceinline__ const bf16_t* opB(const Gemm&, const Unit& u) const { return u.which ? B1 : B0; }
    __device__ __forceinline__ void a_ready(const Unit&) const {}
    __device__ __forceinline__ void done(const Unit&) const {}
};
__device__ __forceinline__ unsigned cvt_pk_bf16(float lo, float hi) { return pk2(lo, hi); }

struct EpiBf16 {
    static constexpr bool PERM = true, KSCALE = false, AFTER_DRAIN = false;
    bf16_t* O; int mode_;
    const float* ss2; bf16_t* O1;
    __device__ __forceinline__ float tok_rstd(int tok) const { const f32x4 p0 = *(const f32x4*)(ss2 + (size_t)tok * 8), p1 = *(const f32x4*)(ss2 + (size_t)tok * 8 + 4);
        return rsqrtf((((p0[0] + p0[1]) + (p0[2] + p0[3])) + ((p1[0] + p1[1]) + (p1[2] + p1[3]))) * (1.0f / DM) + EPS); }
    __device__ __forceinline__ void operator()(const f32x4 (&acc)[2][2][4][2], const Unit& u, int wr, int wc, int fr, int fq) const {
        const int row0 = u.pm * BM + wr * 64 + fr; const int col0 = u.pn * BM + wc * 32 + 8 * fq;
        const int mode = mode_ < 0 ? u.which : mode_; bf16_t* const Ob = (mode_ < 0 && u.which) ? O1 : O;
        const size_t rstep = mode == 0 ? (size_t)16 * 128 : (size_t)16 * 64, hstepr = mode == 0 ? (size_t)HALF * 128 : (size_t)HALF * 64;
        const size_t cstep = mode == 0 ? (size_t)NTOK * 128 : (size_t)2 * NVT * 64;
        bf16_t* base = Ob + (mode == 0 ? zaddr(row0, col0) : vaddr(row0, col0));
#pragma unroll
        for (int ai = 0; ai < 2; ++ai)
#pragma unroll
            for (int m = 0; m < 4; ++m) { bf16_t* rowp = base + ai * hstepr + m * rstep;
#pragma unroll
                for (int bj = 0; bj < 2; ++bj) { const f32x4 v0 = acc[ai][bj][m][0], v1 = acc[ai][bj][m][1];
                    u32x4 w; w.x = cvt_pk_bf16(v0[0], v0[1]); w.y = cvt_pk_bf16(v0[2], v0[3]); w.z = cvt_pk_bf16(v1[0], v1[1]); w.w = cvt_pk_bf16(v1[2], v1[3]);
                    *(u32x4*)(rowp + bj * cstep) = w; } }
    }
};
struct EpiF32SS {
    static constexpr bool PERM = false, KSCALE = true;
    __device__ __forceinline__ void kscale(f32x4 (&acc)[2][2][4][2], int t, PG8_LAS unsigned char* lds, int wr, int fr) const {
        const PG8_LAS float* tab = (const PG8_LAS float*)(lds + 131072) + ((t >> 2) - 1) * 256 + wr * 64 + fr;
#pragma unroll
        for (int ai = 0; ai < 2; ++ai)
#pragma unroll
            for (int m = 0; m < 4; ++m) { const float r = tab[ai * HALF + m * 16];
#pragma unroll
                for (int bj = 0; bj < 2; ++bj)
#pragma unroll
                    for (int n = 0; n < 2; ++n) acc[ai][bj][m][n] *= r; }
        asm volatile("s_waitcnt lgkmcnt(0)" ::: "memory");
    }
    static constexpr bool AFTER_DRAIN = true;
    const float* xin; float* out; const float* gpost; const float* gpre; bf16_t* H; float* ssy; float* ss2; unsigned* cnt; int wantH;
    __device__ __forceinline__ void operator()(const f32x4 (&)[2][2][4][2], const Unit&, int, int, int, int) const {}
    __device__ __forceinline__ void fused(f32x4 (&acc)[2][2][4][2], const Unit& u, int wr, int wc, int fr, int fq, PG8_LAS unsigned char* lds, int tid) const {
        PG8_LAS float* P = (PG8_LAS float*)lds;
        PG8_LAS float* Srow = (PG8_LAS float*)(lds + 4096);
        const int col0 = u.pn * BM + wc * 32 + 4 * fq;
        f32x4 xa[4][4], gpo[4];
#pragma unroll
        for (int q = 0; q < 4; ++q) gpo[q] = *(const f32x4*)(gpost + col0 + (q >> 1) * HALF + (q & 1) * 16);
#pragma unroll
        for (int m = 0; m < 4; ++m)
#pragma unroll
            for (int q = 0; q < 4; ++q) xa[m][q] = *(const f32x4*)(xin + (size_t)(u.pm * BM + wr * 64 + m * 16 + fr) * DM + col0 + (q >> 1) * HALF + (q & 1) * 16);
#pragma unroll
        for (int ai = 0; ai < 2; ++ai)
#pragma unroll
            for (int m = 0; m < 4; ++m) { float s = 0.f;
#pragma unroll
                for (int bj = 0; bj < 2; ++bj)
#pragma unroll
                    for (int n = 0; n < 2; ++n) { const f32x4 x = acc[ai][bj][m][n]; s += (x[0] * x[0] + x[1] * x[1]) + (x[2] * x[2] + x[3] * x[3]); }
                s += __shfl_xor(s, 16); s += __shfl_xor(s, 32);
                if (fq == 0) P[(ai * HALF + wr * 64 + m * 16 + fr) * 4 + wc] = s; }
        asm volatile("s_waitcnt lgkmcnt(0)" ::: "memory"); __builtin_amdgcn_s_barrier(); asm volatile("" ::: "memory");
        if (tid < 256) { const f32x4 p = ((const PG8_LAS f32x4*)P)[tid];
            __hip_atomic_store(ssy + (size_t)(u.pm * BM + tid) * 8 + u.pn, (p[0] + p[1]) + (p[2] + p[3]), __ATOMIC_RELAXED, __HIP_MEMORY_SCOPE_AGENT); }
        asm volatile("s_waitcnt vmcnt(0)" ::: "memory"); __builtin_amdgcn_s_barrier(); asm volatile("" ::: "memory");
        if (tid == 0) {
            __hip_atomic_fetch_add(cnt + 16 * u.pm, 1u, __ATOMIC_RELAXED, __HIP_MEMORY_SCOPE_AGENT);
            unsigned sp = 0;
            while (__hip_atomic_load(cnt + 16 * u.pm, __ATOMIC_RELAXED, __HIP_MEMORY_SCOPE_AGENT) < 8u) { __builtin_amdgcn_s_sleep(2); if (++sp > (1u << 22)) break; }
            __builtin_amdgcn_fence(__ATOMIC_ACQUIRE, "agent");
            asm volatile("s_waitcnt vmcnt(0)" ::: "memory");
        }
        __builtin_amdgcn_s_barrier(); asm volatile("" ::: "memory");
        if (tid < 256) { const float* sl = ssy + (size_t)(u.pm * BM + tid) * 8; float t = 0.f;
#pragma unroll
            for (int q = 0; q < 8; ++q) t += __hip_atomic_load(sl + q, __ATOMIC_RELAXED, __HIP_MEMORY_SCOPE_AGENT);
            Srow[tid] = rsqrtf(t * (1.0f / DM) + EPS); }
        asm volatile("s_waitcnt lgkmcnt(0)" ::: "memory"); __builtin_amdgcn_s_barrier(); asm volatile("" ::: "memory");
#pragma unroll
        for (int ai = 0; ai < 2; ++ai)
#pragma unroll
            for (int m = 0; m < 4; ++m) { const int r = ai * HALF + wr * 64 + m * 16 + fr; const float rstd = Srow[r]; const size_t off = (size_t)(u.pm * BM + r) * DM + col0; float s2 = 0.f;
#pragma unroll
                for (int q = 0; q < 4; ++q) { const int bj = q >> 1, n = q & 1, co = bj * HALF + n * 16;
                    const f32x4 xn = xa[m][q] + acc[ai][bj][m][n] * rstd * gpo[q];
                    *(f32x4*)(out + off + co) = xn; s2 += (xn[0] * xn[0] + xn[1] * xn[1]) + (xn[2] * xn[2] + xn[3] * xn[3]);
                    acc[ai][bj][m][n] = xn; }
                if (ai == 0) {
#pragma unroll
                    for (int q = 0; q < 4; ++q) xa[m][q] = *(const f32x4*)(xin + off + (size_t)HALF * DM + (q >> 1) * HALF + (q & 1) * 16); }
                s2 += __shfl_xor(s2, 16); s2 += __shfl_xor(s2, 32);
                if (fq == 0) P[r * 4 + wc] = s2; }
        asm volatile("s_waitcnt lgkmcnt(0)" ::: "memory"); __builtin_amdgcn_s_barrier(); asm volatile("" ::: "memory");
        if (!wantH) return;
        if (tid < 256) { const f32x4 p = ((const PG8_LAS f32x4*)P)[tid];
            __hip_atomic_store(ss2 + (size_t)(u.pm * BM + tid) * 8 + u.pn, (p[0] + p[1]) + (p[2] + p[3]), __ATOMIC_RELAXED, __HIP_MEMORY_SCOPE_AGENT); }
        asm volatile("s_waitcnt vmcnt(0)" ::: "memory"); __builtin_amdgcn_s_barrier(); asm volatile("" ::: "memory");
        if (tid == 0) {
            __hip_atomic_fetch_add(cnt + 16 * u.pm + 1, 1u, __ATOMIC_RELAXED, __HIP_MEMORY_SCOPE_AGENT);
            unsigned sp = 0;
            while (__hip_atomic_load(cnt + 16 * u.pm + 1, __ATOMIC_RELAXED, __HIP_MEMORY_SCOPE_AGENT) < 8u) { __builtin_amdgcn_s_sleep(2); if (++sp > (1u << 22)) break; }
            __builtin_amdgcn_fence(__ATOMIC_ACQUIRE, "agent");
            asm volatile("s_waitcnt vmcnt(0)" ::: "memory");
        }
        __builtin_amdgcn_s_barrier(); asm volatile("" ::: "memory");
        if (tid < 256) { const float* sl = ss2 + (size_t)(u.pm * BM + tid) * 8; float t = 0.f;
#pragma unroll
            for (int q = 0; q < 8; ++q) t += __hip_atomic_load(sl + q, __ATOMIC_RELAXED, __HIP_MEMORY_SCOPE_AGENT);
            Srow[tid] = rsqrtf(t * (1.0f / DM) + EPS); }
        asm volatile("s_waitcnt lgkmcnt(0)" ::: "memory"); __builtin_amdgcn_s_barrier(); asm volatile("" ::: "memory");
#pragma unroll
        for (int ai = 0; ai < 2; ++ai)
#pragma unroll
            for (int m = 0; m < 4; ++m) { const int r = ai * HALF + wr * 64 + m * 16 + fr; const float r2 = Srow[r]; const size_t off = (size_t)(u.pm * BM + r) * DM + col0;
#pragma unroll
                for (int bj = 0; bj < 2; ++bj)
#pragma unroll
                    for (int n = 0; n < 2; ++n) { const int co = bj * HALF + n * 16; const f32x4 xn = acc[ai][bj][m][n] * r2, gp4 = *(const f32x4*)(gpre + col0 + co);
                        u32x2 w; w.x = pk2(xn[0] * gp4[0], xn[1] * gp4[1]); w.y = pk2(xn[2] * gp4[2], xn[3] * gp4[3]); *(u32x2*)(H + off + co) = w; } }
    }
};

template <class Epi, class Sched, bool ALIGN_EPI = true, bool SP2 = true>
__device__ __forceinline__ void gemm_phase(PG8_LAS unsigned char* lds, const Gemm g, const Sched& S, const Epi& E) {
    int tid_l = threadIdx.x; asm volatile("" : "+v"(tid_l));
    const int tid = tid_l, wid = __builtin_amdgcn_readfirstlane(tid >> 6), lane = tid & 63, wr = wid >> 2, wc = wid & 3, fr = lane & 15, fq = lane >> 4;
    const int K = g.K, nt = K / BK;
    unsigned voffA[2], voffB[2];
#pragma unroll
    for (int i = 0; i < 2; ++i) { int R, C; stage_rc(tid * 16 + i * 8192, R, C); const int Rb = Epi::PERM ? ((R & ~31) + perm32(R & 31)) : R;
        voffA[i] = (unsigned)(R * K + C) * 2u; voffB[i] = (unsigned)(Rb * K + C) * 2u; }
    const size_t kstep = (size_t)(BK * 2);
    const size_t hstep = (size_t)HALF * K * 2;
    const size_t tstep = 2 * hstep;
    const unsigned ldsw = (unsigned)wid * 1024u;
    const int aoff = lds_byte(wr * 64 + fr, fq * 8), boff = lds_byte(wc * 32 + fr, fq * 8);
#define PG8_SA(b, h) (((b) * 2 + (h)) * HTB)
#define PG8_SB(b, h) ((4 + (b) * 2 + (h)) * HTB)
#define PG8_STAGE(bufoff, gbase, voff) do { _Pragma("unroll") for (int _i = 0; _i < 2; ++_i) \
        __builtin_amdgcn_global_load_lds((const unsigned*)((const char*)(gbase) + (voff)[_i]), (PG8_LAS unsigned*)(lds + (bufoff) + ldsw + _i * 8192), 16, 0, 0); } while (0)
#define PG8_LDA(dst, b, h) do { _Pragma("unroll") for (int m = 0; m < 4; ++m) _Pragma("unroll") for (int k = 0; k < 2; ++k) dst[m][k] = *(const PG8_LAS bf16x8*)(lds + PG8_SA(b, h) + aoff + m * 2048 + k * 1024); } while (0)
#define PG8_LDB(dst, b, h) do { _Pragma("unroll") for (int n = 0; n < 2; ++n) _Pragma("unroll") for (int k = 0; k < 2; ++k) dst[n][k] = *(const PG8_LAS bf16x8*)(lds + PG8_SB(b, h) + boff + n * 2048 + k * 1024); } while (0)
#define PG8_MMA(ai, bj, At, Bt) do { __builtin_amdgcn_s_setprio(1); _Pragma("unroll") for (int m = 0; m < 4; ++m) _Pragma("unroll") for (int n = 0; n < 2; ++n) _Pragma("unroll") for (int k = 0; k < 2; ++k) \
        acc[ai][bj][m][n] = __builtin_amdgcn_mfma_f32_16x16x32_bf16(Bt[n][k], At[m][k], acc[ai][bj][m][n], 0, 0, 0); __builtin_amdgcn_s_setprio(0); } while (0)
#define PG8_WAIT_V(n) asm volatile("s_waitcnt vmcnt(" #n ")" ::: "memory")
#define PG8_WAIT_L(n) asm volatile("s_waitcnt lgkmcnt(" #n ")" ::: "memory")
#define PG8_BAR __builtin_amdgcn_s_barrier()
#define PG8_SCHED __builtin_amdgcn_sched_barrier(0)
    Unit cur, nxt; int ui = 0;
    if (!S.next(0, cur)) return;
    f32x4 acc[2][2][4][2];
#pragma unroll
    for (int a = 0; a < 2; ++a)
#pragma unroll
        for (int b = 0; b < 2; ++b)
#pragma unroll
            for (int m = 0; m < 4; ++m)
#pragma unroll
                for (int n = 0; n < 2; ++n) acc[a][b][m][n] = (f32x4){0.f, 0.f, 0.f, 0.f};
    bf16x8 At[4][2], B0[2][2], B1[2][2];
    const char* cA = (const char*)S.opA(g, cur) + (size_t)cur.pm * tstep; const char* cB = (const char*)S.opB(g, cur) + (size_t)cur.pn * tstep;
    S.a_ready(cur);
    if constexpr (SP2) {
        PG8_STAGE(PG8_SB(0, 0), cB, voffB); PG8_STAGE(PG8_SB(0, 1), cB + hstep, voffB); PG8_STAGE(PG8_SA(0, 0), cA, voffA); PG8_STAGE(PG8_SA(0, 1), cA + hstep, voffA);
        if (wr == 1) PG8_BAR;
        PG8_WAIT_V(2); PG8_BAR;
        PG8_STAGE(PG8_SB(1, 0), cB + kstep, voffB); PG8_STAGE(PG8_SA(1, 0), cA + kstep, voffA); PG8_STAGE(PG8_SB(1, 1), cB + hstep + kstep, voffB);
        PG8_WAIT_V(6); PG8_BAR;
    } else {
        PG8_STAGE(PG8_SB(0, 0), cB, voffB); PG8_STAGE(PG8_SA(0, 0), cA, voffA); PG8_STAGE(PG8_SB(0, 1), cB + hstep, voffB); PG8_STAGE(PG8_SA(0, 1), cA + hstep, voffA);
        if (wr == 1) PG8_BAR;
        PG8_WAIT_V(4); PG8_BAR;
        PG8_STAGE(PG8_SB(1, 0), cB + kstep, voffB); PG8_STAGE(PG8_SA(1, 0), cA + kstep, voffA); PG8_STAGE(PG8_SB(1, 1), cB + hstep + kstep, voffB);
        PG8_WAIT_V(6); PG8_BAR;
    }
    for (;;) {
        const bool has_next = S.next(ui + 1, nxt);
        const char* nA = has_next ? (const char*)S.opA(g, nxt) + (size_t)nxt.pm * tstep : cA; const char* nB = has_next ? (const char*)S.opB(g, nxt) + (size_t)nxt.pn * tstep : cB;
        for (int t = 0; t < nt; t += 2) {
            const bool last = (t == nt - 2);
            const char* a1 = cA + (size_t)(t + 1) * kstep;
            const char* a2 = last ? nA : cA + (size_t)(t + 2) * kstep; const char* b2 = last ? nB : cB + (size_t)(t + 2) * kstep;
            const char* a3 = a2 + kstep; const char* b3 = b2 + kstep;
            if (last && has_next) S.a_ready(nxt);
            if constexpr (Epi::KSCALE) { if (t >= 4 && t <= 16 && (t & 3) == 0) { E.kscale(acc, t, lds, wr, fr); PG8_SCHED; } }
            if constexpr (SP2) {
            PG8_LDB(B0, 0, 0); PG8_LDB(B1, 0, 1); PG8_SCHED; PG8_LDA(At, 0, 0); PG8_STAGE(PG8_SA(1, 1), a1 + hstep, voffA);
            PG8_WAIT_V(8); PG8_WAIT_L(0); PG8_BAR; PG8_MMA(0, 0, At, B0); PG8_MMA(0, 1, At, B1); PG8_BAR; PG8_SCHED;
            PG8_LDA(At, 0, 1); PG8_STAGE(PG8_SB(0, 0), b2, voffB); PG8_STAGE(PG8_SB(0, 1), b2 + hstep, voffB); PG8_STAGE(PG8_SA(0, 0), a2, voffA);
            PG8_WAIT_V(8); PG8_WAIT_L(0); PG8_BAR; PG8_MMA(1, 0, At, B0); PG8_MMA(1, 1, At, B1); PG8_BAR; PG8_SCHED;
            PG8_LDB(B0, 1, 0); PG8_LDB(B1, 1, 1); PG8_SCHED; PG8_LDA(At, 1, 0); PG8_STAGE(PG8_SA(0, 1), a2 + hstep, voffA);
            PG8_WAIT_V(8); PG8_WAIT_L(0); PG8_BAR; PG8_MMA(0, 0, At, B0); PG8_MMA(0, 1, At, B1); PG8_BAR; PG8_SCHED;
            PG8_LDA(At, 1, 1); PG8_STAGE(PG8_SB(1, 0), b3, voffB); PG8_STAGE(PG8_SB(1, 1), b3 + hstep, voffB); PG8_STAGE(PG8_SA(1, 0), a3, voffA);
            PG8_WAIT_V(8); PG8_WAIT_L(0); PG8_BAR; PG8_MMA(1, 0, At, B0); PG8_MMA(1, 1, At, B1); PG8_BAR; PG8_SCHED;
            } else {
            PG8_LDB(B0, 0, 0); PG8_SCHED; PG8_LDA(At, 0, 0); PG8_STAGE(PG8_SA(1, 1), a1 + hstep, voffA);
            PG8_WAIT_L(8); PG8_BAR; PG8_WAIT_L(0); PG8_MMA(0, 0, At, B0); PG8_BAR; PG8_SCHED;
            PG8_LDB(B1, 0, 1); PG8_STAGE(PG8_SB(0, 0), b2, voffB);
            PG8_BAR; PG8_WAIT_L(0); PG8_MMA(0, 1, At, B1); PG8_BAR;
            PG8_LDA(At, 0, 1); PG8_STAGE(PG8_SA(0, 0), a2, voffA);
            PG8_BAR; PG8_WAIT_L(0); PG8_MMA(1, 0, At, B0); PG8_BAR; PG8_SCHED;
            PG8_STAGE(PG8_SB(0, 1), b2 + hstep, voffB);
            PG8_WAIT_V(6); PG8_BAR; PG8_MMA(1, 1, At, B1); PG8_BAR;
            PG8_LDB(B0, 1, 0); PG8_SCHED; PG8_LDA(At, 1, 0); PG8_STAGE(PG8_SA(0, 1), a2 + hstep, voffA);
            PG8_WAIT_L(8); PG8_BAR; PG8_WAIT_L(0); PG8_MMA(0, 0, At, B0); PG8_BAR; PG8_SCHED;
            PG8_LDB(B1, 1, 1); PG8_STAGE(PG8_SB(1, 0), b3, voffB);
            PG8_BAR; PG8_WAIT_L(0); PG8_MMA(0, 1, At, B1); PG8_BAR;
            PG8_LDA(At, 1, 1); PG8_STAGE(PG8_SA(1, 0), a3, voffA);
            PG8_BAR; PG8_WAIT_L(0); PG8_MMA(1, 0, At, B0); PG8_BAR; PG8_SCHED;
            PG8_STAGE(PG8_SB(1, 1), b3 + hstep, voffB);
            PG8_WAIT_V(6); PG8_BAR; PG8_MMA(1, 1, At, B1); PG8_BAR;
            }
        }
        if constexpr (ALIGN_EPI) { if (wr == 0) PG8_BAR; }
        if constexpr (!Epi::AFTER_DRAIN) { E(acc, cur, wr, wc, fr, fq); S.done(cur); }
        if (!has_next) break;
#pragma unroll
        for (int a = 0; a < 2; ++a)
#pragma unroll
            for (int b = 0; b < 2; ++b)
#pragma unroll
                for (int m = 0; m < 4; ++m)
#pragma unroll
                    for (int n = 0; n < 2; ++n) acc[a][b][m][n] = (f32x4){0.f, 0.f, 0.f, 0.f};
        cur = nxt; cA = nA; cB = nB; ++ui;
        if constexpr (ALIGN_EPI) { if (wr == 1) PG8_BAR; }
    }
    PG8_WAIT_V(0);
    if constexpr (!ALIGN_EPI) { if (wr == 0) PG8_BAR; }
    PG8_BAR;
    if constexpr (Epi::AFTER_DRAIN) { E.fused(acc, cur, wr, wc, fr, fq, lds, tid); }
#undef PG8_SA
#undef PG8_SB
#undef PG8_STAGE
#undef PG8_LDA
#undef PG8_LDB
#undef PG8_MMA
#undef PG8_WAIT_V
#undef PG8_WAIT_L
#undef PG8_BAR
#undef PG8_SCHED
}
}

struct Args {
    const float* x; const float* w_in; const float* w_out; const float* g_pre; const float* g_post;
    const float* w_alpha; const float* b_alpha; const float* g_gla; const float* g_att; const float* rel_bias;
    float* out; unsigned char* ws;
    int ph_lo, ph_hi, coop, pad;
};

typedef const __attribute__((address_space(4))) Args* KArgs;
__device__ __forceinline__ KArgs fresh_args() { KArgs p = (KArgs)__builtin_amdgcn_kernarg_segment_ptr(); asm volatile("" : "+s"(p)); return p; }
__device__ __forceinline__ bf16_t* win_dest(int j, bf16_t* W1T, bf16_t* WVT) {
    if (j < 1024) return W1T + (size_t)j * DM;
    if (j < 2048) return WVT + (size_t)(j - 1024) * DM;
    if (j < 3072) return W1T + (size_t)(j - 1024) * DM;
    if (j < 3088) return W1T + (size_t)(ZGA + (j - 3072)) * DM;
    if (j < 4112) return W1T + (size_t)(ZAQ + (j - 3088)) * DM;
    if (j < 5136) return W1T + (size_t)(ZAK + (j - 4112)) * DM;
    if (j < 6160) return WVT + (size_t)(1024 + (j - 5136)) * DM;
    return W1T + (size_t)(ZAG + (j - 6160)) * DM;
}
template <bool IS_IN>
__device__ __forceinline__ void p0_item(const float* W, int N, LAS float* scr, int item, int lane, bf16_t* D0, bf16_t* D1) {
    const int nblk = (N + 63) / 64, kb = item / nblk, nb = item % nblk, k0 = 64 * kb, n0 = 64 * nb;
    const int n4 = (lane & 15) * 4; const bool okr = n0 + n4 < N;
    const float* wp = W + (size_t)(k0 + (lane >> 4)) * N + n0 + n4;
    f32x4 v[16];
#pragma unroll
    for (int i = 0; i < 16; ++i) v[i] = okr ? __builtin_nontemporal_load((const f32x4*)(wp + (size_t)(4 * i) * N)) : (f32x4){0.f, 0.f, 0.f, 0.f};
#pragma unroll
    for (int i = 0; i < 16; ++i) { LAS float* s = scr + (4 * i + (lane >> 4)) * 65 + n4; s[0] = v[i][0]; s[1] = v[i][1]; s[2] = v[i][2]; s[3] = v[i][3]; }
    LDS_WAIT(); asm volatile("" ::: "memory");
    const int c = lane & 7;
#pragma unroll
    for (int j = 0; j < 8; ++j) { const int n = (lane >> 3) + 8 * j; const LAS float* s = scr + (8 * c) * 65 + n;
        u32x4 o; o.x = pk2(s[0 * 65], s[1 * 65]); o.y = pk2(s[2 * 65], s[3 * 65]); o.z = pk2(s[4 * 65], s[5 * 65]); o.w = pk2(s[6 * 65], s[7 * 65]);
        const int ns = n0 + n;
        if (ns < N) { bf16_t* d = IS_IN ? win_dest(ns, D0, D1) : D0 + (size_t)ns * DM; __builtin_nontemporal_store(o, (u32x4*)(d + k0 + 8 * c)); } }
    LDS_WAIT(); asm volatile("" ::: "memory");
}

__device__ __forceinline__ void rowpass0(KArgs a) {
    const int tid = opaque_tid(), lane = tid & 63, gw = blockIdx.x * NWAVES + (tid >> 6), NGW = gridDim.x * NWAVES;
    bf16_t* H = (bf16_t*)(a->ws + WS_H);
    f32x4 nx[8];
    { const f32x4* xr = (const f32x4*)(a->x + (size_t)(gw < NTOK ? gw : 0) * DM) + lane;
#pragma unroll
      for (int j = 0; j < 8; ++j) nx[j] = xr[64 * j]; }
    for (int row = gw; row < NTOK; row += NGW) {
        f32x4 v[8];
#pragma unroll
        for (int j = 0; j < 8; ++j) v[j] = nx[j];
        { const int rn = row + NGW < NTOK ? row + NGW : row; const f32x4* xr = (const f32x4*)(a->x + (size_t)rn * DM) + lane;
#pragma unroll
          for (int j = 0; j < 8; ++j) nx[j] = xr[64 * j]; }
        float s = 0.f;
#pragma unroll
        for (int j = 0; j < 8; ++j) s += (v[j][0] * v[j][0] + v[j][1] * v[j][1]) + (v[j][2] * v[j][2] + v[j][3] * v[j][3]);
        s = wave_sum(s);
        const float r2 = rsqrtf(s * (1.0f / DM) + EPS);
        const f32x4* gq = (const f32x4*)a->g_pre + lane; u32x2* ho = (u32x2*)(H + (size_t)row * DM) + lane;
#pragma unroll
        for (int j = 0; j < 8; ++j) { const f32x4 g = gq[64 * j]; u32x2 w; w.x = pk2(v[j][0] * r2 * g[0], v[j][1] * r2 * g[1]); w.y = pk2(v[j][2] * r2 * g[2], v[j][3] * r2 * g[3]); ho[64 * j] = w; }
    }
}

__device__ __forceinline__ void convert_layer(KArgs a, int l, LAS unsigned char* lds, int wk, int nwk) {
    const int tid0 = opaque_tid(), lane = tid0 & 63, wave = __builtin_amdgcn_readfirstlane(tid0 >> 6);
    LAS float* scr = (LAS float*)(lds + wave * 16640);
    constexpr int I_IN = 32 * 113, I_OUT = 32 * 32;
    bf16_t* W1T = (bf16_t*)(a->ws + WS_W1T) + (size_t)l * LDZ * DM; bf16_t* WVT = (bf16_t*)(a->ws + WS_WVT) + (size_t)l * DM * DM; bf16_t* WOT = (bf16_t*)(a->ws + WS_WOT) + (size_t)l * DM * DM;
    for (int r = wk; r < I_IN + I_OUT; r += nwk) {
        if (r < I_IN) p0_item<true>(a->w_in + (size_t)l * DM * D_IN, D_IN, scr, r, lane, W1T, WVT);
        else p0_item<false>(a->w_out + (size_t)l * DM * DM, DM, scr, r - I_IN, lane, WOT, nullptr);
    }
}
__device__ __forceinline__ void p0_phase(KArgs a, LAS unsigned char* lds) {
    const int tid0 = opaque_tid(), lane = tid0 & 63, wave = __builtin_amdgcn_readfirstlane(tid0 >> 6);
    LAS float* scr = (LAS float*)(lds + wave * 16640);
    const int gw = blockIdx.x * NWAVES + wave, NGW = gridDim.x * NWAVES;
    constexpr int I_IN = 32 * 113, I_OUT = 32 * 32, NITEMS = DEPTH * (I_IN + I_OUT);
    bf16_t* W1T = (bf16_t*)(a->ws + WS_W1T); bf16_t* WVT = (bf16_t*)(a->ws + WS_WVT); bf16_t* WOT = (bf16_t*)(a->ws + WS_WOT);
    convert_layer(a, 0, lds, gw, NGW);
    { const int tid = blockIdx.x * NTHR + tid0, NT = gridDim.x * NTHR; constexpr int PADV = 240 * DM / 8;
      for (int i = tid; i < DEPTH * PADV; i += NT) { const int l = i / PADV, r = i % PADV; *((u32x4*)(W1T + (size_t)l * LDZ * DM + (size_t)(ZGA + 16) * DM) + r) = (u32x4){0u, 0u, 0u, 0u}; }
    }
    if (blockIdx.x == 0) { for (int i = tid0; i < 1024; i += NTHR) ((unsigned*)(a->ws + WS_CTR))[i] = 0u; }
    if (blockIdx.x == 1) { for (int i = tid0; i < (DEPTH * 32 + 2 * DEPTH) * 16; i += NTHR) ((unsigned*)(a->ws + WS_PCN))[i] = 0u; }
    rowpass0(a);
}

__device__ __forceinline__ void attn_naive_item(KArgs a, int l, int item) {
    const int tid = opaque_tid();
    const bf16_t* Z = (const bf16_t*)(a->ws + WS_Z1); const bf16_t* VT = (const bf16_t*)(a->ws + WS_VT); bf16_t* MB = (bf16_t*)(a->ws + WS_MB);
    const int h = item & 7, c = (item >> 3) & 31, b = item >> 8;
    const int qi = tid >> 3, dp = tid & 7;
    const int tokq = b * SEQ + c * CHUNK + qi;
    const float* rb = a->rel_bias + ((size_t)l * 8 + h) * 257;
    float q[16], acc[16];
#pragma unroll
    for (int i = 0; i < 16; ++i) { q[i] = bf2f(Z[(size_t)tokq * LDZ + ZAQ + h * 128 + dp * 16 + i]); acc[i] = 0.f; }
    float mx = -1e30f, ls = 0.f;
    const int kc0 = c - 8 < 0 ? 0 : c - 8;
    for (int kc = kc0; kc <= c; ++kc)
        for (int j = 0; j < CHUNK; ++j) {
            const int tokk = b * SEQ + kc * CHUNK + j;
            const bf16_t* kr = Z + (size_t)tokk * LDZ + ZAK + h * 128 + dp * 16;
            float s = 0.f;
#pragma unroll
            for (int i = 0; i < 16; ++i) s += q[i] * bf2f(kr[i]);
            s += __shfl_xor(s, 1); s += __shfl_xor(s, 2); s += __shfl_xor(s, 4);
            int rel = (c - kc) * CHUNK + qi - j; rel = rel > 128 ? 128 : (rel < -128 ? -128 : rel);
            s = s * 0.08838834764831845f + rb[rel + 128];
            const float mn = fmaxf(mx, s), corr = __expf(mx - mn), p = __expf(s - mn);
            ls = ls * corr + p; mx = mn;
#pragma unroll
            for (int i = 0; i < 16; ++i) acc[i] = acc[i] * corr + p * bf2f(VT[(size_t)(1024 + h * 128 + dp * 16 + i) * NTOK + tokk]);
        }
    float ss = 0.f; const float inv = 1.0f / ls;
#pragma unroll
    for (int i = 0; i < 16; ++i) { acc[i] *= inv; ss += acc[i] * acc[i]; }
    ss += __shfl_xor(ss, 1); ss += __shfl_xor(ss, 2); ss += __shfl_xor(ss, 4);
    const float rstd = rsqrtf(ss * (1.0f / 128.0f) + EPS);
#pragma unroll
    for (int i = 0; i < 16; ++i) { const int d = h * 128 + dp * 16 + i;
        const float g = a->g_att[(size_t)l * 1024 + d], gate = bf2f(Z[(size_t)tokq * LDZ + ZAG + d]);
        MB[(size_t)tokq * DM + 1024 + d] = (bf16_t)f2bf(acc[i] * rstd * g * silu_f(gate)); }
}
__device__ __forceinline__ void gla_naive_item(KArgs a, int l, int item, LAS unsigned char* lds) {
    const int tid = opaque_tid();
    const bf16_t* Z = (const bf16_t*)(a->ws + WS_Z1); const bf16_t* VT = (const bf16_t*)(a->ws + WS_VT); float* OR = (float*)(a->ws + WS_ORAW);
    LAS float* L = (LAS float*)lds;
    LAS float* S = L + 64 * 128;
    const int vt = item & 15, h = (item >> 4) & 3, b = item >> 6;
    for (int i = tid; i < 128 * 16; i += NTHR) S[i] = 0.f;
    float wal[16]; float bal = 0.f;
    if (tid < 128) { for (int r = 0; r < 16; ++r) wal[r] = a->w_alpha[((size_t)l * 16 + r) * 512 + h * 128 + tid]; bal = a->b_alpha[(size_t)l * 512 + h * 128 + tid]; }
    __syncthreads();
    for (int c = 0; c < NCH; ++c) {
        const int tok0 = b * SEQ + c * CHUNK;
        if (tid < 128) { float cum = 0.f;
            for (int s = 0; s < CHUNK; ++s) { const bf16_t* gr = Z + (size_t)(tok0 + s) * LDZ + ZGA; float x = bal;
#pragma unroll
                for (int r = 0; r < 16; ++r) x += bf2f(gr[r]) * wal[r];
                cum += logsigmoid_f(x) * (1.0f / 16.0f); L[s * 128 + tid] = cum; } }
        __syncthreads();
        { const int k = tid & 127, vq = tid >> 7; const float Le = L[63 * 128 + k], Ae = __expf(Le);
          float acc[4];
#pragma unroll
          for (int i = 0; i < 4; ++i) acc[i] = S[k * 16 + vq * 4 + i] * Ae;
          for (int s = 0; s < CHUNK; ++s) { const float kd = bf2f(Z[(size_t)(tok0 + s) * LDZ + ZGK + h * 128 + k]) * __expf(Le - L[s * 128 + k]);
#pragma unroll
              for (int i = 0; i < 4; ++i) acc[i] += kd * bf2f(VT[(size_t)(h * 256 + vt * 16 + vq * 4 + i) * NTOK + tok0 + s]); }
#pragma unroll
          for (int i = 0; i < 4; ++i) S[k * 16 + vq * 4 + i] = acc[i]; }
        __syncthreads();
        { const int s = tid >> 3, v2 = (tid & 7) * 2; float o0 = 0.f, o1 = 0.f; const bf16_t* qr = Z + (size_t)(tok0 + s) * LDZ + ZGQ + h * 128;
          for (int k = 0; k < 128; ++k) { const float qv = bf2f(qr[k]); o0 += qv * S[k * 16 + v2]; o1 += qv * S[k * 16 + v2 + 1]; }
          float* op = OR + (size_t)(tok0 + s) * 1024 + h * 256 + vt * 16 + v2; op[0] = o0 * 0.08838834764831845f; op[1] = o1 * 0.08838834764831845f; }
        __syncthreads();
    }
}
__device__ __forceinline__ void gla_norm_phase(KArgs a, int l) {
    const int tid = opaque_tid(), lane = tid & 63, gw = blockIdx.x * NWAVES + (tid >> 6), NGW = gridDim.x * NWAVES;
    const bf16_t* Z = (const bf16_t*)(a->ws + WS_Z1); const float* OR = (const float*)(a->ws + WS_ORAW); bf16_t* MB = (bf16_t*)(a->ws + WS_MB);
    for (int it = gw; it < NTOK * 4; it += NGW) { const int tok = it >> 2, h = it & 3;
        const f32x4 o = *((const f32x4*)(OR + (size_t)tok * 1024 + h * 256) + lane);
        const float ss = wave_sum((o[0] * o[0] + o[1] * o[1]) + (o[2] * o[2] + o[3] * o[3]));
        const float rstd = rsqrtf(ss * (1.0f / 256.0f) + EPS);
        const f32x4 g = *((const f32x4*)(a->g_gla + (size_t)l * 1024 + h * 256) + lane);
        const bf16_t* gg = Z + (size_t)tok * LDZ + ZGG + h * 256 + lane * 4;
        u32x2 w; w.x = pk2(o[0] * rstd * g[0] * silu_f(bf2f(gg[0])), o[1] * rstd * g[1] * silu_f(bf2f(gg[1])));
        w.y = pk2(o[2] * rstd * g[2] * silu_f(bf2f(gg[2])), o[3] * rstd * g[3] * silu_f(bf2f(gg[3])));
        *((u32x2*)(MB + (size_t)tok * DM + h * 256) + lane) = w; }
}


constexpr int AT_KS = 0, AT_VS = 34816, AT_PS = 71680, AT_BIAS = 90112;
__device__ __forceinline__ void attn_item(KArgs a, int l, int item, LAS unsigned char* lds) {
    const int tid = opaque_tid();
    const bf16_t* Z = (const bf16_t*)(a->ws + WS_Z1); const bf16_t* VT = (const bf16_t*)(a->ws + WS_VT); bf16_t* MB = (bf16_t*)(a->ws + WS_MB);
    const int hp = item & 3, c = (item >> 2) & 31, b = item >> 7;
    const int lane = tid & 63, w = __builtin_amdgcn_readfirstlane(tid >> 6), hh = w >> 2, wq = w & 3, h = 2 * hp + hh;
    const int l15 = lane & 15, lg = lane >> 4;
    const int tq0 = b * SEQ + c * CHUNK;
    bf16x8 qf[4];
    { const bf16_t* qp = Z + zaddr(tq0 + wq * 16 + l15, ZAQ + h * 128 + 8 * lg);
#pragma unroll
      for (int j = 0; j < 4; ++j) qf[j] = *(const bf16x8*)(qp + 32 * j); }
    f32x4 o[8]; float mrow = -1e30f, lsum = 0.f;
#pragma unroll
    for (int i = 0; i < 8; ++i) o[i] = (f32x4){0.f, 0.f, 0.f, 0.f};
    const int kc0 = c - 8 < 0 ? 0 : c - 8;
    const bf16_t* kg = Z + zaddr(b * SEQ + (tid >> 5), ZAK + 2 * hp * 128 + (tid & 31) * 8);
    const bf16_t* vg = VT + vaddr(1024 + 2 * hp * 128 + (tid >> 3), b * SEQ + (tid & 7) * 8);
    const int kl = AT_KS + ((((tid & 31) >> 4) * 64 + (tid >> 5)) * 136 + ((tid & 31) & 15) * 8) * 2;
    const int vl = AT_VS + ((tid >> 3) * 72 + (tid & 7) * 8) * 2;
    u32x4 kreg[4], vreg[4];
#pragma unroll
    for (int i = 0; i < 4; ++i) { kreg[i] = *(const u32x4*)(kg + (size_t)(kc0 * CHUNK + 16 * i) * 128); vreg[i] = *(const u32x4*)(vg + (size_t)(64 * i) * 64 + (size_t)kc0 * NVT * 64); }
    const LAS float* bt = (const LAS float*)(lds + AT_BIAS) + hh * 260;
    constexpr float SC2 = 0.08838834764831845f * 1.4426950408889634f;
    const int qi = wq * 16 + l15;
    for (int kc = kc0; kc <= c; ++kc) {
        __syncthreads();
#pragma unroll
        for (int i = 0; i < 4; ++i) { *(LAS u32x4*)(lds + kl + i * 16 * 136 * 2) = kreg[i]; *(LAS u32x4*)(lds + vl + i * 64 * 72 * 2) = vreg[i]; }
        if (kc == kc0) { for (int i = tid; i < 2 * 257; i += NTHR) { const int hb = i / 257, r = i % 257; ((LAS float*)(lds + AT_BIAS))[hb * 260 + r] = a->rel_bias[((size_t)l * 8 + 2 * hp + hb) * 257 + r] * 1.4426950408889634f; } }
        __syncthreads();
        if (kc < c) {
#pragma unroll
            for (int i = 0; i < 4; ++i) { kreg[i] = *(const u32x4*)(kg + (size_t)((kc + 1) * CHUNK + 16 * i) * 128); vreg[i] = *(const u32x4*)(vg + (size_t)(64 * i) * 64 + (size_t)(kc + 1) * NVT * 64); }
        }
        f32x4 s[4];
        { const LAS unsigned char* kb_ = lds + AT_KS + ((hh * 64 + l15) * 136 + 8 * lg) * 2;
#pragma unroll
          for (int nh = 0; nh < 2; ++nh) { bf16x8 kf[2][4];
#pragma unroll
              for (int n2 = 0; n2 < 2; ++n2)
#pragma unroll
                  for (int j = 0; j < 4; ++j) kf[n2][j] = *(const LAS bf16x8*)(kb_ + (2 * nh + n2) * (16 * 136 * 2) + 64 * j);
              __builtin_amdgcn_sched_barrier(0);
#pragma unroll
              for (int n2 = 0; n2 < 2; ++n2) { f32x4 acc_ = (f32x4){0.f, 0.f, 0.f, 0.f};
#pragma unroll
                  for (int j = 0; j < 4; ++j) acc_ = __builtin_amdgcn_mfma_f32_16x16x32_bf16(kf[n2][j], qf[j], acc_, 0, 0, 0);
                  s[2 * nh + n2] = acc_; }
              __builtin_amdgcn_sched_barrier(0); } }
        float mloc = -1e30f;
        if (c - kc >= 3) {
            const float bc = bt[256];
#pragma unroll
            for (int n = 0; n < 4; ++n)
#pragma unroll
                for (int r = 0; r < 4; ++r) { s[n][r] = s[n][r] * SC2 + bc; mloc = fmaxf(mloc, s[n][r]); }
        } else {
            const int relbase = (c - kc) * CHUNK + qi - 4 * lg;
#pragma unroll
            for (int n = 0; n < 4; ++n)
#pragma unroll
                for (int r = 0; r < 4; ++r) { int rel = relbase - 16 * n - r; rel = rel > 128 ? 128 : (rel < -128 ? -128 : rel);
                    s[n][r] = s[n][r] * SC2 + bt[rel + 128]; mloc = fmaxf(mloc, s[n][r]); }
        }
        mloc = fmaxf(mloc, __shfl_xor(mloc, 16)); mloc = fmaxf(mloc, __shfl_xor(mloc, 32));
        const float mn = fmaxf(mrow, mloc), corr = __builtin_amdgcn_exp2f(mrow - mn); mrow = mn; lsum *= corr;
        bf16x8 pf[2];
#pragma unroll
        for (int t = 0; t < 2; ++t) { float pv[8];
#pragma unroll
            for (int e = 0; e < 8; ++e) { pv[e] = __builtin_amdgcn_exp2f(s[2 * t + (e >> 2)][e & 3] - mrow); lsum += pv[e]; }
            const u32x4 pw4 = (u32x4){pk2(pv[0], pv[1]), pk2(pv[2], pv[3]), pk2(pv[4], pv[5]), pk2(pv[6], pv[7])};
            pf[t] = __builtin_bit_cast(bf16x8, pw4); }
#pragma unroll
        for (int nd = 0; nd < 8; ++nd) o[nd] *= corr;
        { const LAS unsigned char* vb_ = lds + AT_VS + ((hh * 128 + l15) * 72 + 4 * lg) * 2;
#pragma unroll
          for (int nq = 0; nq < 2; ++nq) { u32x4 vv[4][2];
#pragma unroll
              for (int n4 = 0; n4 < 4; ++n4)
#pragma unroll
                  for (int t = 0; t < 2; ++t) { const LAS unsigned char* vp_ = vb_ + (4 * nq + n4) * (16 * 72 * 2) + 64 * t;
                      const u32x2 va = *(const LAS u32x2*)vp_, vb = *(const LAS u32x2*)(vp_ + 32); vv[n4][t] = (u32x4){va.x, va.y, vb.x, vb.y}; }
              __builtin_amdgcn_sched_barrier(0);
#pragma unroll
              for (int n4 = 0; n4 < 4; ++n4)
#pragma unroll
                  for (int t = 0; t < 2; ++t) o[4 * nq + n4] = __builtin_amdgcn_mfma_f32_16x16x32_bf16(__builtin_bit_cast(bf16x8, vv[n4][t]), pf[t], o[4 * nq + n4], 0, 0, 0);
              __builtin_amdgcn_sched_barrier(0); } }
    }
    float lt = lsum; lt += __shfl_xor(lt, 16); lt += __shfl_xor(lt, 32);
    const float inv = 1.0f / lt; float ss = 0.f;
#pragma unroll
    for (int nd = 0; nd < 8; ++nd)
#pragma unroll
        for (int r = 0; r < 4; ++r) { o[nd][r] *= inv; ss += o[nd][r] * o[nd][r]; }
    ss += __shfl_xor(ss, 16); ss += __shfl_xor(ss, 32);
    const float rstd = rsqrtf(ss * (1.0f / 128.0f) + EPS); const int tok = tq0 + qi;
#pragma unroll
    for (int nd = 0; nd < 8; ++nd) { const int d = h * 128 + 16 * nd + 4 * lg;
        const f32x4 g = *(const f32x4*)(a->g_att + (size_t)l * 1024 + d); const u32x2 gw = *(const u32x2*)(Z + zaddr(tok, ZAG + d));
        const float g0 = __uint_as_float(gw.x << 16), g1 = __uint_as_float(gw.x & 0xffff0000u), g2 = __uint_as_float(gw.y << 16), g3 = __uint_as_float(gw.y & 0xffff0000u);
        u32x2 ow; ow.x = pk2(o[nd][0] * rstd * g[0] * silu_f(g0), o[nd][1] * rstd * g[1] * silu_f(g1)); ow.y = pk2(o[nd][2] * rstd * g[2] * silu_f(g2), o[nd][3] * rstd * g[3] * silu_f(g3));
        *(u32x2*)(MB + (size_t)tok * DM + 1024 + d) = ow; }
}

constexpr int GL_GA = 0, GL_TOT = 4096, GL_ST = 8192, GL_O = 8192 + 17408;
__device__ __forceinline__ void gla_prep_item(KArgs a, int l, int item, LAS unsigned char* lds) {
    const int tid = opaque_tid();
    const bf16_t* Z = (const bf16_t*)(a->ws + WS_Z1); bf16_t* KD = (bf16_t*)(a->ws + WS_KD) + (size_t)item * 8192; float* AD = (float*)(a->ws + WS_AD) + (size_t)item * 128;
    const int c = item & 31, h = (item >> 5) & 3, b = item >> 7;
    const int pk = tid & 127, sq = tid >> 7, tok0 = b * SEQ + c * CHUNK;
    float wal[16];
#pragma unroll
    for (int r = 0; r < 16; ++r) wal[r] = a->w_alpha[((size_t)l * 16 + r) * 512 + h * 128 + pk];
    const float bal = a->b_alpha[(size_t)l * 512 + h * 128 + pk];
    const unsigned ga2 = *(const unsigned*)(Z + zaddr(tok0 + (tid >> 3), ZGA + (tid & 7) * 2));
    bf16_t kv[16];
#pragma unroll
    for (int i = 0; i < 16; ++i) kv[i] = Z[zaddr(tok0 + 16 * sq + i, ZGK + h * 128 + pk)];
    LAS float* gaS = (LAS float*)(lds + GL_GA); LAS float* tot = (LAS float*)(lds + GL_TOT);
    __syncthreads();
    gaS[(tid >> 3) * 16 + (tid & 7) * 2] = __uint_as_float(ga2 << 16); gaS[(tid >> 3) * 16 + (tid & 7) * 2 + 1] = __uint_as_float(ga2 & 0xffff0000u);
    __syncthreads();
    float Lloc[16]; float cum = 0.f;
#pragma unroll
    for (int i = 0; i < 16; ++i) { const LAS f32x4* gr = (const LAS f32x4*)(gaS + (16 * sq + i) * 16); float x = bal;
#pragma unroll
        for (int r4 = 0; r4 < 4; ++r4) { const f32x4 g4 = gr[r4]; x += g4[0] * wal[4 * r4] + g4[1] * wal[4 * r4 + 1] + g4[2] * wal[4 * r4 + 2] + g4[3] * wal[4 * r4 + 3]; }
        cum += logsigmoid_fast(x) * (1.0f / 16.0f); Lloc[i] = cum; }
    tot[sq * 128 + pk] = cum;
    __syncthreads();
    float off = 0.f, Lend = 0.f;
#pragma unroll
    for (int q = 0; q < 4; ++q) { const float t = tot[q * 128 + pk]; off += (q < sq) ? t : 0.f; Lend += t; }
    unsigned wd[8];
#pragma unroll
    for (int i = 0; i < 8; ++i) wd[i] = pk2(bf2f(kv[2 * i]) * __expf(Lend - (off + Lloc[2 * i])), bf2f(kv[2 * i + 1]) * __expf(Lend - (off + Lloc[2 * i + 1])));
    *(u32x4*)(KD + pk * 64 + 16 * sq) = (u32x4){wd[0], wd[1], wd[2], wd[3]};
    *(u32x4*)(KD + pk * 64 + 16 * sq + 8) = (u32x4){wd[4], wd[5], wd[6], wd[7]};
    if (sq == 0) AD[pk] = __expf(Lend);
}
struct GlaK { u32x4 k0, k1, v0; };
struct GlaQ { bf16x8 qf[4]; };
constexpr int GL_ADT = 8192;
constexpr int GL_ST0 = GL_ADT + 16384, GL_STB = 17408;
constexpr int GL_O0 = GL_ST0 + 2 * GL_STB, GL_OB = 16640; constexpr int GL_KV0 = GL_O0 + 2 * GL_OB, GL_KVB = 27648;
__device__ __forceinline__ float fast_silu(float x) { return x * __builtin_amdgcn_rcpf(1.0f + __expf(-x)); }
__device__ __forceinline__ void gla_chain(KArgs a, int l, int item, LAS unsigned char* lds) {
    const int tid = opaque_tid(), lane = tid & 63, w = __builtin_amdgcn_readfirstlane(tid >> 6);
    const bf16_t* Z = (const bf16_t*)(a->ws + WS_Z1); const bf16_t* VT = (const bf16_t*)(a->ws + WS_VT); bf16_t* MB = (bf16_t*)(a->ws + WS_MB); float* SSP = (float*)(a->ws + WS_SSP);
    const int j = item & 3, h = (item >> 2) & 3, b = item >> 4;
    const int kt = w >> 1, vt = w & 1, l31 = lane & 31, lh = lane >> 5;
    const int sti = w & 3, vh = w >> 2, l15 = lane & 15, lg = lane >> 4;
    const int es = tid >> 3, evq = tid & 7;
    const bf16_t* kp = (const bf16_t*)(a->ws + WS_KD) + (size_t)((b * 4 + h) * 32) * 8192 + (tid >> 3) * 64 + (tid & 7) * 8;
    const bf16_t* vp = VT + vaddr(h * 256 + 64 * j + (tid >> 3), b * SEQ + (tid & 7) * 8);
    const int kvw = ((tid >> 3) * 72 + (tid & 7) * 8) * 2;
    const int kur = ((32 * kt + l31) * 72 + 8 * lh) * 2, vur = 18432 + ((32 * vt + l31) * 72 + 8 * lh) * 2;
    const bf16_t* qp = Z + zaddr(b * SEQ + 16 * sti + l15, ZGQ + h * 128 + 8 * lg);
    const bf16_t* gp = Z + zaddr(b * SEQ + es, ZGG + h * 256 + 64 * j + 8 * evq);
    bf16_t* mp = MB + (size_t)(b * SEQ + es) * DM + h * 256 + 64 * j + 8 * evq;
    float* sp = SSP + ((size_t)(b * SEQ + es) * 4 + h) * 4 + j;
#define GLA_LDK(dst) do { (dst).k0 = *(const u32x4*)kp; (dst).k1 = *(const u32x4*)(kp + 64 * 64); (dst).v0 = *(const u32x4*)vp; kp += 8192; vp += (size_t)NVT * 64; } while (0)
#define GLA_STK(src, buf) do { LAS unsigned char* kb_ = lds + GL_KV0 + (buf) * GL_KVB + kvw; asm volatile("" : "+v"(kb_)); \
        *(LAS u32x4*)kb_ = (src).k0; *(LAS u32x4*)(kb_ + 64 * 72 * 2) = (src).k1; *(LAS u32x4*)(kb_ + 18432) = (src).v0; } while (0)
#define GLA_LDQ(dst) do { _Pragma("unroll") for (int i_ = 0; i_ < 4; ++i_) (dst).qf[i_] = *(const bf16x8*)(qp + 32 * i_); qp += (size_t)CHUNK * 128; } while (0)
    GlaK K0, K1, K2; GlaQ Q0, Q1, Q2; u32x4 G0, G1, G2;
    GLA_LDK(K0); GLA_LDK(K1); GLA_LDK(K2); GLA_LDQ(Q0);
    G0 = G1 = G2 = (u32x4){0u, 0u, 0u, 0u}; Q1 = Q0; Q2 = Q0;
    GLA_STK(K0, 0); GLA_LDK(K0);
    float gl[8];
    { const f32x4* gg4 = (const f32x4*)(a->g_gla + (size_t)l * 1024 + h * 256 + 64 * j + 8 * evq); const f32x4 ga_ = gg4[0], gb_ = gg4[1];
      gl[0] = ga_[0]; gl[1] = ga_[1]; gl[2] = ga_[2]; gl[3] = ga_[3]; gl[4] = gb_[0]; gl[5] = gb_[1]; gl[6] = gb_[2]; gl[7] = gb_[3]; }
    { const f32x4* adg = (const f32x4*)((const float*)(a->ws + WS_AD) + (size_t)((b * 4 + h) * 32) * 128); LAS f32x4* adl = (LAS f32x4*)(lds + GL_ADT);
      adl[tid] = adg[tid]; adl[tid + 512] = adg[tid + 512]; }
    f32x16 S;
#pragma unroll
    for (int i = 0; i < 16; ++i) S[i] = 0.f;
    __syncthreads();
#define GLA_ITER(i, DO_LD, DO_U, DO_O, DO_E, KU, KL, QU, QL, GU, GL_) do { const int i_t = (i); \
        if (DO_LD) { GLA_STK(KL, (i_t + 1) & 1); GLA_LDK(KL); GLA_LDQ(QL); GL_ = *(const u32x4*)gp; gp += (size_t)CHUNK * 128; }     \
        if (DO_U) {                                                                          \
            _Pragma("unroll") for (int rg = 0; rg < 4; ++rg) { const f32x4 ad = *(const LAS f32x4*)(lds + GL_ADT + (i_t * 128 + 32 * kt + 8 * rg + 4 * lh) * 4); \
                _Pragma("unroll") for (int q_ = 0; q_ < 4; ++q_) S[4 * rg + q_] *= ad[q_]; } \
            { LAS unsigned char* kvb_ = lds + GL_KV0 + (i_t & 1) * GL_KVB; asm volatile("" : "+v"(kvb_)); bf16x8 kf_[4], vf_[4]; \
              _Pragma("unroll") for (int ss = 0; ss < 4; ++ss) { kf_[ss] = *(const LAS bf16x8*)(kvb_ + kur + 32 * ss); vf_[ss] = *(const LAS bf16x8*)(kvb_ + vur + 32 * ss); } \
              _Pragma("unroll") for (int ss = 0; ss < 4; ++ss) S = __builtin_amdgcn_mfma_f32_32x32x16_bf16(kf_[ss], vf_[ss], S, 0, 0, 0); } \
            LAS unsigned char* sw_ = lds + GL_ST0 + (i_t & 1) * GL_STB + ((32 * vt + l31) * 136 + 32 * kt + 4 * lh) * 2; asm volatile("" : "+v"(sw_));     \
            _Pragma("unroll") for (int rg = 0; rg < 4; ++rg) { u32x2 wv; wv.x = pg8::cvt_pk_bf16(S[4 * rg], S[4 * rg + 1]); wv.y = pg8::cvt_pk_bf16(S[4 * rg + 2], S[4 * rg + 3]); \
                *(LAS u32x2*)(sw_ + 16 * rg) = wv; } } \
        if (DO_O) {                                                                          \
            f32x4 oa[2] = {(f32x4){0.f, 0.f, 0.f, 0.f}, (f32x4){0.f, 0.f, 0.f, 0.f}}; \
            LAS unsigned char* sr_ = lds + GL_ST0 + ((i_t - 1) & 1) * GL_STB + ((32 * vh + l15) * 136 + 8 * lg) * 2; asm volatile("" : "+v"(sr_)); \
            bf16x8 bfr[4][2]; \
            _Pragma("unroll") for (int kk = 0; kk < 4; ++kk) \
                _Pragma("unroll") for (int t = 0; t < 2; ++t) bfr[kk][t] = *(const LAS bf16x8*)(sr_ + t * (16 * 136 * 2) + kk * 64); \
            __builtin_amdgcn_sched_barrier(0);                                               \
            _Pragma("unroll") for (int kk = 0; kk < 4; ++kk) \
                _Pragma("unroll") for (int t = 0; t < 2; ++t) oa[t] = __builtin_amdgcn_mfma_f32_16x16x32_bf16((QU).qf[kk], bfr[kk][t], oa[t], 0, 0, 0); \
            LAS float* oS_ = (LAS float*)(lds + GL_O0 + ((i_t - 1) & 1) * GL_OB) + (16 * sti + 4 * lg) * 65 + 32 * vh + l15; asm volatile("" : "+v"(oS_)); \
            _Pragma("unroll") for (int t = 0; t < 2; ++t) \
                _Pragma("unroll") for (int r = 0; r < 4; ++r) oS_[r * 65 + 16 * t] = oa[t][r] * 0.08838834764831845f; } \
        if (DO_E) {                                                                          \
            const LAS float* oS_ = (const LAS float*)(lds + GL_O0 + (i_t & 1) * GL_OB) + es * 65 + 8 * evq; asm volatile("" : "+v"(oS_)); float ov[8]; float ss = 0.f; \
            _Pragma("unroll") for (int q_ = 0; q_ < 8; ++q_) { ov[q_] = oS_[q_]; ss += ov[q_] * ov[q_]; } \
            ss += __builtin_bit_cast(float, __builtin_amdgcn_mov_dpp(__builtin_bit_cast(int, ss), 0xB1, 0xF, 0xF, true));      \
            ss += __builtin_bit_cast(float, __builtin_amdgcn_mov_dpp(__builtin_bit_cast(int, ss), 0x4E, 0xF, 0xF, true));      \
            ss += __builtin_bit_cast(float, __builtin_amdgcn_mov_dpp(__builtin_bit_cast(int, ss), 0x141, 0xF, 0xF, true));     \
            if (evq == 0) *sp = ss; sp += CHUNK * 16; \
            const unsigned gw4[4] = {(GU).x, (GU).y, (GU).z, (GU).w}; unsigned ow[4]; \
            _Pragma("unroll") for (int q_ = 0; q_ < 4; ++q_) { const float g0 = __uint_as_float(gw4[q_] << 16), g1 = __uint_as_float(gw4[q_] & 0xffff0000u); \
                ow[q_] = pg8::cvt_pk_bf16(ov[2 * q_] * gl[2 * q_] * fast_silu(g0), ov[2 * q_ + 1] * gl[2 * q_ + 1] * fast_silu(g1)); } \
            *(u32x4*)mp = (u32x4){ow[0], ow[1], ow[2], ow[3]}; mp += (size_t)CHUNK * DM; } \
        asm volatile("s_waitcnt lgkmcnt(0)" ::: "memory"); __builtin_amdgcn_s_barrier(); asm volatile("" ::: "memory"); \
    } while (0)
    GLA_ITER(0, true, true, false, false, K0, K1, Q2, Q1, G1, G0); GLA_ITER(1, true, true, true, false, K1, K2, Q0, Q2, G2, G1);
#pragma nounroll
    for (int i = 2; i < 32; i += 3) { GLA_ITER(i, true, true, true, true, K2, K0, Q1, Q0, G0, G2); GLA_ITER(i + 1, true, true, true, true, K0, K1, Q2, Q1, G1, G0); GLA_ITER(i + 2, true, true, true, true, K1, K2, Q0, Q2, G2, G1); }
    GLA_ITER(32, false, false, true, true, K2, K1, Q1, Q0, G0, G2); GLA_ITER(33, false, false, false, true, K0, K2, Q2, Q1, G1, G0);
    __syncthreads();
#undef GLA_ITER
#undef GLA_LDK
#undef GLA_LDQ
}

#define XB_TMO      128
#define XB_XCNT(j)  (256  + 64 * (j))
#define XB_XSUB(j)  (1280 + 64 * (j))
#define XB_XGEN(j)  (2304 + 64 * (j))
#define XB_TOP      3328
#define XB_TOPGEN   3392
#define XCD_BAR_WORDS 3456
#define XB_SPIN_CAP (1u << 18)
__device__ __forceinline__ unsigned xb_ld(unsigned* p)              { return __hip_atomic_load(p, __ATOMIC_RELAXED, __HIP_MEMORY_SCOPE_AGENT); }
__device__ __forceinline__ unsigned xb_add(unsigned* p, unsigned v) { return __hip_atomic_fetch_add(p, v, __ATOMIC_RELAXED, __HIP_MEMORY_SCOPE_AGENT); }
__device__ __forceinline__ unsigned xb_xcc_id() { return (unsigned)__builtin_amdgcn_s_getreg((3 << 11) | 20) & 0xFu; }
#define XB_SPIN(cond, bar) do { unsigned _sp = 0; while (cond) { __builtin_amdgcn_s_sleep(1); \
    if ((++_sp & 255u) == 0u) { if (xb_ld(&(bar)[XB_TMO])) break; if (_sp > XB_SPIN_CAP) { atomicAdd(&(bar)[XB_TMO], 1u); break; } } } } while (0)
__device__ __forceinline__ void xcd_barrier_complete(unsigned* bar, unsigned x, unsigned& nloc, unsigned& nx) {
    const unsigned G = gridDim.x * gridDim.y * gridDim.z;
    unsigned sum, cnt, mine, sp = 0u;
    for (;;) {
        sum = 0u; cnt = 0u; mine = 0u;
#pragma unroll
        for (unsigned j = 0; j < 16; ++j) { const unsigned c = xb_ld(&bar[XB_XCNT(j)]); sum += c; cnt += (c > 0u) ? 1u : 0u; mine = (j == x) ? c : mine; }
        if (sum == G) break;
        __builtin_amdgcn_s_sleep(1);
        if ((++sp & 255u) == 0u) { if (xb_ld(&bar[XB_TMO])) break; if (sp > XB_SPIN_CAP) { atomicAdd(&bar[XB_TMO], 1u); break; } }
    }
    nloc = mine > 0u ? mine : 1u; nx = cnt > 0u ? cnt : 1u;
}
__device__ __forceinline__ void xcd_barrier(unsigned* bar, volatile LAS unsigned* st) {
    asm volatile("s_waitcnt vmcnt(0)" ::: "memory");
    __syncthreads();
    if (threadIdx.x == 0) {
        const unsigned x = xb_xcc_id();
        __builtin_amdgcn_s_waitcnt(0);
        unsigned nloc = st[0], nx = st[1];
        if (nloc == 0u) { xcd_barrier_complete(bar, x, nloc, nx); st[0] = nloc; st[1] = nx; }
        const unsigned old = xb_add(&bar[XB_XSUB(x)], 1u);
        const unsigned gen = old / nloc;
        if (old + 1u == (gen + 1u) * nloc) {
            __builtin_amdgcn_fence(__ATOMIC_RELEASE, "agent");
            asm volatile("s_waitcnt vmcnt(0)" ::: "memory");
            const unsigned og = xb_add(&bar[XB_TOP], 1u);
            const unsigned tg = og / nx;
            if (og + 1u == (tg + 1u) * nx) xb_add(&bar[XB_TOPGEN], 1u);
            else XB_SPIN(xb_ld(&bar[XB_TOPGEN]) == tg, bar);
            __builtin_amdgcn_fence(__ATOMIC_ACQUIRE, "agent");
            xb_add(&bar[XB_XGEN(x)], 1u);
            asm volatile("s_waitcnt vmcnt(0)" ::: "memory");
        } else {
            XB_SPIN(xb_ld(&bar[XB_XGEN(x)]) == gen, bar);
            __builtin_amdgcn_fence(__ATOMIC_ACQUIRE, "agent");
            asm volatile("s_waitcnt vmcnt(0)" ::: "memory");
        }
    }
    __syncthreads();
}
constexpr int LDS_XB = 159696;
#define GRID_BAR() xcd_barrier((unsigned*)(fresh_args()->ws + WS_BAR), (volatile LAS unsigned*)(lds + LDS_XB))

constexpr int NPHASES = 1 + 5 * DEPTH;
#ifndef PROBE
#define PROBE 0
#endif
__global__ void __launch_bounds__(NTHR) mk_fwd(Args a_unused) {
    extern __shared__ __attribute__((aligned(16))) unsigned char lds_raw[];
    LAS unsigned char* lds = (LAS unsigned char*)lds_raw;
    { unsigned* bar0 = (unsigned*)(fresh_args()->ws + WS_BAR);
      if (threadIdx.x == 0) { ((volatile LAS unsigned*)(lds + LDS_XB))[0] = 0u; ((volatile LAS unsigned*)(lds + LDS_XB))[1] = 0u;
        (void)xb_add(&bar0[XB_XCNT(xb_xcc_id())], 1u); } }
    __syncthreads();
#define IN(k) (fresh_args()->ph_lo <= (k) && (k) < fresh_args()->ph_hi)
#define SEAM(k) do { if (fresh_args()->coop && IN(k) && IN((k) + 1)) { GRID_BAR(); } } while (0)
    if (fresh_args()->coop == 2) cg::this_grid().sync();
    if (IN(0)) { p0_phase(fresh_args(), lds); }
    if (PROBE == 1) { for (int i = 0; i < 16; ++i) GRID_BAR(); }
    if (PROBE == 2) { cg::this_grid().sync(); p0_phase(fresh_args(), lds); }
    SEAM(0);
#pragma nounroll
    for (int l = 0; l < DEPTH; ++l) {
        const int pb = 1 + 5 * l;
        if (IN(pb)) for (int rep_ = 0; rep_ < (PROBE == 3 ? 2 : 1); ++rep_) {
            KArgs a = fresh_args();
            pg8::DualOrder SD; SD.s0.init(NTOK, LDZ, gridDim.x, blockIdx.x, 8); SD.s1.init(NVT, NTOK, gridDim.x, blockIdx.x, 8); SD.G = gridDim.x; SD.c = blockIdx.x;
            SD.A0 = (const bf16_t*)(a->ws + WS_H); SD.B0 = (const bf16_t*)(a->ws + WS_W1T) + (size_t)l * LDZ * DM;
            SD.A1 = (const bf16_t*)(a->ws + WS_WVT) + (size_t)l * DM * DM; SD.B1 = (const bf16_t*)(a->ws + WS_H);
            pg8::Gemm g1{SD.A0, SD.B0, NTOK, LDZ, DM};
            pg8::EpiBf16 E1{(bf16_t*)(a->ws + WS_Z1), -1, (const float*)(a->ws + WS_SS2), (bf16_t*)(a->ws + WS_VT)};
            pg8::gemm_phase<pg8::EpiBf16, pg8::DualOrder, false, true>(lds, g1, SD, E1);
            if (rep_ == 0 && l + 1 < DEPTH && blockIdx.x >= 160 && gridDim.x == 256) convert_layer(fresh_args(), l + 1, lds, (blockIdx.x - 160) * NWAVES + __builtin_amdgcn_readfirstlane(opaque_tid() >> 6), 96 * NWAVES);
            else if (rep_ == 0 && l + 1 < DEPTH && gridDim.x != 256) convert_layer(fresh_args(), l + 1, lds, blockIdx.x * NWAVES + __builtin_amdgcn_readfirstlane(opaque_tid() >> 6), gridDim.x * NWAVES);
        }
        SEAM(pb);
        if (IN(pb + 1)) for (int rep_ = 0; rep_ < (PROBE == 4 ? 2 : 1); ++rep_) {
#ifdef NAIVE_GLA
            for (int it = blockIdx.x; it < 512; it += gridDim.x) attn_item(fresh_args(), l, it, lds);
            for (int it = blockIdx.x; it < 256; it += gridDim.x) { __syncthreads(); gla_naive_item(fresh_args(), l, it, lds); }
#else
            const int x0 = blockIdx.x & 7;
            unsigned* evt = (unsigned*)(fresh_args()->ws + WS_PCN) + (DEPTH * 32 + l * 2 + rep_) * 16;
            const bool chainwg = blockIdx.x < 64 && gridDim.x == 256;
            if (!chainwg) {
                const int nprep = gridDim.x == 256 ? 192 : (int)gridDim.x, pid = gridDim.x == 256 ? (int)blockIdx.x - 64 : (int)blockIdx.x;
                for (int it = pid; it < 512; it += nprep) gla_prep_item(fresh_args(), l, it, lds);
                asm volatile("s_waitcnt vmcnt(0)" ::: "memory"); __syncthreads();
                if (threadIdx.x == 0) { __builtin_amdgcn_fence(__ATOMIC_RELEASE, "agent"); asm volatile("s_waitcnt vmcnt(0)" ::: "memory"); __hip_atomic_fetch_add(evt, 1u, __ATOMIC_RELAXED, __HIP_MEMORY_SCOPE_AGENT); }
            }
            if (gridDim.x != 256) { if (fresh_args()->coop) GRID_BAR(); }
            if (blockIdx.x < 64) {
                if (chainwg) {
                    unsigned* qh0 = (unsigned*)(fresh_args()->ws + WS_CTR) + ((l * 2 + rep_) * 8 + x0) * 16;
                    __syncthreads();
                    if (threadIdx.x == 0) { int q_ = 64; if (__hip_atomic_load(qh0, __ATOMIC_RELAXED, __HIP_MEMORY_SCOPE_AGENT) < 64u) q_ = (int)atomicAdd(qh0, 1u); *(LAS int*)(lds + 159680) = q_; }
                    __syncthreads();
                    const int q = *(LAS int*)(lds + 159680);
                    if (q < 64) { const int pair = 2 * x0 + (q & 1), c = 31 - (q >> 1); attn_item(fresh_args(), l, ((pair >> 2) << 7) | (c << 2) | (pair & 3), lds); }
                    __syncthreads();
                    if (threadIdx.x == 0) { unsigned sp = 0;
                        while (__hip_atomic_load(evt, __ATOMIC_RELAXED, __HIP_MEMORY_SCOPE_AGENT) < 192u) { __builtin_amdgcn_s_sleep(2); if (++sp > (1u << 22)) break; }
                        __builtin_amdgcn_fence(__ATOMIC_ACQUIRE, "agent"); asm volatile("s_waitcnt vmcnt(0)" ::: "memory"); }
                    __syncthreads();
                }
                const int idx = blockIdx.x >> 3; gla_chain(fresh_args(), l, ((2 * x0 + (idx >> 2)) << 2) | (idx & 3), lds);
            }
            for (int dx = 0; dx < 8; ++dx) {
                const int x = (x0 + dx) & 7;
                unsigned* qh = (unsigned*)(fresh_args()->ws + WS_CTR) + ((l * 2 + rep_) * 8 + x) * 16;
                for (;;) {
                    __syncthreads();
                    if (threadIdx.x == 0) { int q_ = 64; if (__hip_atomic_load(qh, __ATOMIC_RELAXED, __HIP_MEMORY_SCOPE_AGENT) < 64u) q_ = (int)atomicAdd(qh, 1u); *(LAS int*)(lds + 159680) = q_; }
                    __syncthreads();
                    const int q = *(LAS int*)(lds + 159680);
                    if (q >= 64) break;
                    const int pair = 2 * x + (q & 1), c = 31 - (q >> 1);
                    attn_item(fresh_args(), l, ((pair >> 2) << 7) | (c << 2) | (pair & 3), lds);
                }
            }
#endif
        }
        SEAM(pb + 1);
#ifdef NAIVE_GLA
        if (IN(pb + 2)) { gla_norm_phase(fresh_args(), l); }
#endif
        SEAM(pb + 2);
        if (IN(pb + 3)) for (int rep_ = 0; rep_ < (PROBE == 5 ? 2 : 1); ++rep_) {
            KArgs a = fresh_args();
            pg8::StaticOrder S3; S3.init(NTOK, DM, gridDim.x, blockIdx.x);
            { pg8::Unit u0; const int t3 = opaque_tid();
              if (S3.next(0, u0) && t3 < 256) { LAS float* tab = (LAS float*)(lds + 131072); float rr[4];
#ifdef NAIVE_GLA
#pragma unroll
                  for (int hq = 0; hq < 4; ++hq) rr[hq] = 1.0f;
#else
                  const f32x4* sp = (const f32x4*)((const float*)(a->ws + WS_SSP) + (size_t)(u0.pm * 256 + t3) * 16);
#pragma unroll
                  for (int hq = 0; hq < 4; ++hq) { const f32x4 p4 = sp[hq]; rr[hq] = rsqrtf(((p4[0] + p4[1]) + (p4[2] + p4[3])) * (1.0f / 256.0f) + EPS); }
#endif
                  tab[t3] = rr[0] / rr[1]; tab[256 + t3] = rr[1] / rr[2]; tab[512 + t3] = rr[2] / rr[3]; tab[768 + t3] = rr[3]; }
              __syncthreads(); }
            pg8::Gemm g3{(const bf16_t*)(a->ws + WS_MB), (const bf16_t*)(a->ws + WS_WOT) + (size_t)l * DM * DM, NTOK, DM, DM};
            pg8::EpiF32SS E3{l == 0 ? a->x : a->out, a->out, a->g_post + (size_t)l * DM, a->g_pre + (size_t)(l + 1 < DEPTH ? l + 1 : 0) * DM, (bf16_t*)(a->ws + WS_H),
                             (float*)(a->ws + WS_SSY), (float*)(a->ws + WS_SS2), (unsigned*)(a->ws + WS_PCN) + (size_t)l * 32 * 16, l + 1 < DEPTH ? 1 : 0};
            pg8::gemm_phase<pg8::EpiF32SS, pg8::StaticOrder>(lds, g3, S3, E3);
        }
        SEAM(pb + 3);
    }
#undef IN
#undef SEAM
}

extern "C" void kernel_launch(void* const* d_in, const int* in_sizes, int n_in, void* d_out, int out_size, void* d_ws, size_t ws_size, hipStream_t stream) {
    static int grid = 0;
    if (grid == 0) {
        if (n_in != 10 || out_size != NTOK * DM || ws_size < WS_END) { fprintf(stderr, "kernel_launch: unexpected shapes (n_in %d out %d ws %zu need %zu)\n", n_in, out_size, ws_size, (size_t)WS_END); grid = -1; return; }
        int dev = 0, cus = 0, per_cu = 0;
        (void)hipGetDevice(&dev); (void)hipDeviceGetAttribute(&cus, hipDeviceAttributeMultiprocessorCount, dev);
        (void)hipFuncSetAttribute((const void*)mk_fwd, hipFuncAttributeMaxDynamicSharedMemorySize, LDS_BYTES);
        (void)hipOccupancyMaxActiveBlocksPerMultiprocessor(&per_cu, (const void*)mk_fwd, NTHR, LDS_BYTES);
        if (per_cu < 1) { fprintf(stderr, "kernel_launch: occupancy query says %d blocks per CU\n", per_cu); per_cu = 1; }
        (void)hipGetLastError();
        grid = cus;
    }
    if (grid < 0) return;
    Args ka{};
    ka.x = (const float*)d_in[0]; ka.w_in = (const float*)d_in[1]; ka.w_out = (const float*)d_in[2]; ka.g_pre = (const float*)d_in[3]; ka.g_post = (const float*)d_in[4];
    ka.w_alpha = (const float*)d_in[5]; ka.b_alpha = (const float*)d_in[6]; ka.g_gla = (const float*)d_in[7]; ka.g_att = (const float*)d_in[8]; ka.rel_bias = (const float*)d_in[9];
    ka.out = (float*)d_out; ka.ws = (unsigned char*)d_ws; ka.pad = 0;
#if 0
    ka.coop = 0;
    for (int p = 0; p < NPHASES; ++p) { ka.ph_lo = p; ka.ph_hi = p + 1; hipLaunchKernelGGL(mk_fwd, dim3(grid), dim3(NTHR), LDS_BYTES, stream, ka); }
#else
    ka.coop = 1; ka.ph_lo = 0; ka.ph_hi = NPHASES;
    (void)hipMemsetAsync((char*)d_ws + WS_BAR, 0, XCD_BAR_WORDS * 4, stream);
    void* args[] = {&ka};
    hipError_t e = hipLaunchCooperativeKernel((const void*)mk_fwd, dim3(grid), dim3(NTHR), args, LDS_BYTES, stream);
    if (e != hipSuccess) fprintf(stderr, "cooperative launch failed: %s (grid %d)\n", hipGetErrorString(e), grid);
#endif
}
```
